# Optimizing an MI355X kernel written in HIP

```python
import math
import jax, jax.numpy as jnp
from jax import lax
import numpy as np


D_MODEL = 1024
BATCH = 2
SEQ = 16384
DEPTH = 1

MIX_WIDTH = D_MODEL
HG_WIDTH = MIX_WIDTH // 2
HG_HEADS = 4
HG_DK = HG_WIDTH // HG_HEADS
HG_CHUNK = 64
S5_WIDTH = MIX_WIDTH - HG_WIDTH
S5_GROUP = 16
S5_GROUPS = S5_WIDTH // S5_GROUP
S5_STATE = 64
IN_WIDTH = 4 * HG_WIDTH + S5_WIDTH
PEER_HEADS = 8
PEER_NKEYS = 128
PEER_EXPERTS = PEER_NKEYS * PEER_NKEYS
PEER_TOPK = 16
PEER_QDIM = 256
PEER_HALF = PEER_QDIM // 2
PEER_TOKEN_BLOCK = 128
EPS = 1e-6

kernel_name = 'hymba_hgrn2_s5_peer_adaln'


def _rmsnorm(x, w):
    xf = x.astype(jnp.float32)
    y = xf * lax.rsqrt(jnp.mean(xf * xf, axis=-1, keepdims=True) + EPS)
    return (y * w.astype(jnp.float32)).astype(x.dtype)


def _hgrn2(q, f_logit, i, g, lb, gn_w):
    bsz, seq, _ = q.shape
    f32 = jnp.float32
    f = lb + (1.0 - lb) * jax.nn.sigmoid(f_logit.astype(f32))
    log_f = jnp.log(f)
    k = 1.0 - f
    qs = jax.nn.silu(q.astype(f32)) * (HG_DK ** -0.5)
    v = i.astype(f32)
    n_chunks = seq // HG_CHUNK

    def to_chunks(t):
        return t.reshape(bsz, n_chunks, HG_CHUNK, HG_HEADS, HG_DK).transpose(1, 0, 3, 2, 4)

    causal = jnp.tril(jnp.ones((HG_CHUNK, HG_CHUNK), dtype=bool))[:, :, None]

    def step(state, inp):
        qc, kc, vc, lc = inp
        bcum = jnp.cumsum(lc, axis=2)
        o_inter = jnp.einsum('bhtk,bhkv->bhtv', qc * jnp.exp(bcum), state)
        diff = bcum[:, :, :, None, :] - bcum[:, :, None, :, :]
        decay = jnp.exp(jnp.where(causal, diff, -jnp.inf))
        scores = jnp.einsum('bhtk,bhsk,bhtsk->bhts', qc, kc, decay)
        o_intra = jnp.einsum('bhts,bhsv->bhtv', scores, vc)
        b_last = bcum[:, :, -1:, :]
        new_state = (jnp.exp(b_last[:, :, 0, :])[..., None] * state
                     + jnp.einsum('bhsk,bhsv->bhkv', kc * jnp.exp(b_last - bcum), vc))
        return new_state, o_inter + o_intra

    s0 = jnp.zeros((bsz, HG_HEADS, HG_DK, HG_DK), f32)
    _, o = lax.scan(step, s0, (to_chunks(qs), to_chunks(k), to_chunks(v), to_chunks(log_f)))
    o = o.transpose(1, 0, 3, 2, 4).reshape(bsz, seq, HG_HEADS, HG_DK)
    gate = jax.nn.silu(g.astype(f32)).reshape(bsz, seq, HG_HEADS, HG_DK)
    o = _rmsnorm(o, gn_w) * gate
    return o.reshape(bsz, seq, HG_WIDTH)


def _s5(u, a_re, a_im, log_dt, b_re, b_im, c_re, c_im, d_skip, w_glu, b_glu):
    bsz, seq, _ = u.shape
    f32 = jnp.float32
    uf = u.astype(f32).reshape(bsz, seq, S5_GROUPS, S5_GROUP)
    ar = a_re.astype(f32)
    ai = a_im.astype(f32)
    dt = jnp.exp(log_dt.astype(f32))[:, None]
    mag = jnp.exp(ar * dt)
    abar_re = mag * jnp.cos(ai * dt)
    abar_im = mag * jnp.sin(ai * dt)
    den = ar * ar + ai * ai
    nr = abar_re - 1.0
    ni = abar_im
    coef_re = ((nr * ar + ni * ai) / den)[..., None]
    coef_im = ((ni * ar - nr * ai) / den)[..., None]
    br = b_re.astype(f32)
    bi = b_im.astype(f32)
    bb_re = coef_re * br - coef_im * bi
    bb_im = coef_re * bi + coef_im * br
    bu_re = jnp.einsum('bsgh,gph->bsgp', uf, bb_re)
    bu_im = jnp.einsum('bsgh,gph->bsgp', uf, bb_im)
    a_re_t = jnp.broadcast_to(abar_re, bu_re.shape)
    a_im_t = jnp.broadcast_to(abar_im, bu_im.shape)

    def combine(e1, e2):
        a1r, a1i, x1r, x1i = e1
        a2r, a2i, x2r, x2i = e2
        return (a2r * a1r - a2i * a1i,
                a2r * a1i + a2i * a1r,
                a2r * x1r - a2i * x1i + x2r,
                a2r * x1i + a2i * x1r + x2i)

    _, _, xr, xi = lax.associative_scan(combine, (a_re_t, a_im_t, bu_re, bu_im), axis=1)
    y = (jnp.einsum('bsgp,ghp->bsgh', xr, c_re.astype(f32))
         - jnp.einsum('bsgp,ghp->bsgh', xi, c_im.astype(f32)))
    y = y.reshape(bsz, seq, S5_WIDTH) + d_skip.astype(f32) * uf.reshape(bsz, seq, S5_WIDTH)
    y = jax.nn.gelu(y, approximate=False)
    y = y * jax.nn.sigmoid(y @ w_glu.astype(f32) + b_glu.astype(f32))
    return y.astype(u.dtype)


def _peer(h, w_q, keys1, keys2, u_tab, v_tab):
    bsz, seq, d = h.shape
    tb = PEER_TOKEN_BLOCK
    blocks = h.reshape(-1, tb, d)
    kk = PEER_TOPK * PEER_TOPK

    def block(hb):
        qh = (hb @ w_q).reshape(tb, PEER_HEADS, 2, PEER_HALF)
        s1 = jnp.einsum('thd,nd->thn', qh[:, :, 0], keys1)
        s2 = jnp.einsum('thd,nd->thn', qh[:, :, 1], keys2)
        v1, i1 = lax.top_k(s1, PEER_TOPK)
        v2, i2 = lax.top_k(s2, PEER_TOPK)
        cand = (v1[..., :, None] + v2[..., None, :]).reshape(tb, PEER_HEADS, kk)
        cidx = (i1[..., :, None] * PEER_NKEYS + i2[..., None, :]).reshape(tb, PEER_HEADS, kk)
        best, pos = lax.top_k(cand, PEER_TOPK)
        eidx = jnp.take_along_axis(cidx, pos, axis=-1)
        gates = jax.nn.softmax(best.astype(jnp.float32), axis=-1).astype(hb.dtype)
        act = jax.nn.gelu(jnp.einsum('td,thkd->thk', hb, u_tab[eidx]), approximate=False)
        return jnp.einsum('thk,thkd->td', gates * act, v_tab[eidx])

    return lax.map(block, blocks).reshape(bsz, seq, d)


def setup_inputs(seed: int = 0) -> dict:
    key = jax.random.key(seed)
    ks = jax.random.split(key, 26)
    f32 = jnp.float32

    def nrm(k, shape, std):
        return std * jax.random.normal(k, shape, f32)

    L = DEPTH
    D = D_MODEL
    G = S5_GROUPS
    P = S5_STATE
    return {
        'x': nrm(ks[0], (BATCH, SEQ, D), 1.0),
        'c': nrm(ks[1], (BATCH, D), 1.0),
        'ada_w': nrm(ks[2], (L, D, 6 * D), 0.5 * D ** -0.5),
        'ada_b': nrm(ks[3], (L, 6 * D), 0.01),
        'norm_mix_w': 1.0 + nrm(ks[4], (L, D), 0.02),
        'norm_ffn_w': 1.0 + nrm(ks[5], (L, D), 0.02),
        'w_in': nrm(ks[6], (L, D, IN_WIDTH), D ** -0.5),
        'w_out': nrm(ks[7], (L, MIX_WIDTH, D), MIX_WIDTH ** -0.5),
        'hg_lower_bounds': nrm(ks[8], (L + 1, HG_WIDTH), 0.1),
        'hg_gnorm_w': 1.0 + nrm(ks[9], (L, HG_DK), 0.02),
        's5_a_re': -0.5 + nrm(ks[10], (L, G, P), 0.01),
        's5_a_im': math.pi * jnp.arange(P, dtype=f32) + nrm(ks[11], (L, G, P), 0.01),
        's5_log_dt': jax.random.uniform(ks[12], (L, G), f32, math.log(1e-3), math.log(1e-1)),
        's5_b_re': nrm(ks[13], (L, G, P, S5_GROUP), (2 * S5_GROUP) ** -0.5),
        's5_b_im': nrm(ks[14], (L, G, P, S5_GROUP), (2 * S5_GROUP) ** -0.5),
        's5_c_re': nrm(ks[15], (L, G, S5_GROUP, P), 0.25),
        's5_c_im': nrm(ks[16], (L, G, S5_GROUP, P), 0.25),
        's5_d': nrm(ks[17], (L, S5_WIDTH), 0.5),
        's5_glu_w': nrm(ks[18], (L, S5_WIDTH, S5_WIDTH), S5_WIDTH ** -0.5),
        's5_glu_b': nrm(ks[19], (L, S5_WIDTH), 0.01),
        'peer_wq': nrm(ks[20], (L, D, PEER_HEADS * PEER_QDIM), D ** -0.5),
        'peer_keys1': nrm(ks[21], (L, PEER_NKEYS, PEER_HALF), PEER_HALF ** -0.5),
        'peer_keys2': nrm(ks[22], (L, PEER_NKEYS, PEER_HALF), PEER_HALF ** -0.5),
        'peer_u': nrm(ks[23], (L, PEER_EXPERTS, D), D ** -0.5),
        'peer_v': nrm(ks[24], (L, PEER_EXPERTS, D), PEER_HEADS ** -0.5),
        'final_norm_w': 1.0 + nrm(ks[25], (D,), 0.02),
    }


def reference(x, c, ada_w, ada_b, norm_mix_w, norm_ffn_w, w_in, w_out, hg_lower_bounds,
              hg_gnorm_w, s5_a_re, s5_a_im, s5_log_dt, s5_b_re, s5_b_im, s5_c_re, s5_c_im,
              s5_d, s5_glu_w, s5_glu_b, peer_wq, peer_keys1, peer_keys2, peer_u, peer_v,
              final_norm_w):
    cond = jax.nn.silu(c)
    lb_all = jnp.cumsum(jax.nn.softmax(hg_lower_bounds.astype(jnp.float32), axis=0), axis=0)
    for l in range(DEPTH):
        mod = (cond @ ada_w[l] + ada_b[l])[:, None, :]
        sh1, sc1, gt1, sh2, sc2, gt2 = jnp.split(mod, 6, axis=-1)
        h = _rmsnorm(x, norm_mix_w[l]) * (1.0 + sc1) + sh1
        proj = h @ w_in[l]
        q, f_logit, i, g, u = jnp.split(
            proj, [HG_WIDTH, 2 * HG_WIDTH, 3 * HG_WIDTH, 4 * HG_WIDTH], axis=-1)
        o_hg = _hgrn2(q, f_logit, i, g, lb_all[l], hg_gnorm_w[l]).astype(x.dtype)
        o_s5 = _s5(u, s5_a_re[l], s5_a_im[l], s5_log_dt[l], s5_b_re[l], s5_b_im[l],
                   s5_c_re[l], s5_c_im[l], s5_d[l], s5_glu_w[l], s5_glu_b[l])
        mixed = jnp.concatenate([o_hg, o_s5], axis=-1) @ w_out[l]
        x = x + gt1 * mixed
        h2 = _rmsnorm(x, norm_ffn_w[l]) * (1.0 + sc2) + sh2
        x = x + gt2 * _peer(h2, peer_wq[l], peer_keys1[l], peer_keys2[l], peer_u[l], peer_v[l])
    return _rmsnorm(x, final_norm_w)
```

```cpp
#include <hip/hip_runtime.h>
#include <hip/hip_cooperative_groups.h>
#include <stdint.h>
#include <stdio.h>
namespace cg = cooperative_groups;

#ifndef ONE_LAUNCH
#define ONE_LAUNCH 0
#endif

typedef unsigned short bf16_t;
typedef __attribute__((ext_vector_type(8))) short bf16x8;
typedef __attribute__((ext_vector_type(4))) float f32x4;
typedef __attribute__((ext_vector_type(2))) __bf16 bf2_t;

constexpr int D = 1024, BATCH = 2, SEQ = 16384, NTOK = BATCH * SEQ;
constexpr int DK = 128;
constexpr int INW = 2560;
constexpr int NT = 512;
constexpr int NWAVE = NT / 64;
constexpr float EPS = 1e-6f;
constexpr int S5_SEG = 512, S5_NSEG = SEQ / S5_SEG;

constexpr size_t MiB = 1024ull * 1024ull;
constexpr size_t OFF_CTL   = 0;
constexpr size_t OFF_MOD   = 64 * 1024;
constexpr size_t OFF_LB    = OFF_MOD + 48 * 1024;
constexpr size_t OFF_S5AB  = OFF_LB + 2048;
constexpr size_t OFF_S5BB  = OFF_S5AB + 32 * 1024;
constexpr size_t OFF_S5END = 1 * MiB;
constexpr size_t OFF_S5CAR = 2 * MiB;
constexpr size_t OFF_HGDEC = 3 * MiB;
constexpr size_t OFF_WIN   = 4 * MiB;
constexpr size_t OFF_WOUT  = 9 * MiB;
constexpr size_t OFF_WGLU  = 11 * MiB;
constexpr size_t OFF_KEYS  = 11 * MiB + 512 * 1024;
constexpr size_t OFF_WQ    = 12 * MiB;
constexpr size_t OFF_UT    = 16 * MiB;
constexpr size_t OFF_VT    = 48 * MiB;
constexpr size_t OFF_H     = 80 * MiB;
constexpr size_t OFF_PROJ  = 144 * MiB;
constexpr size_t OFF_OCAT  = 304 * MiB;
constexpr size_t OFF_HGS   = 368 * MiB;
constexpr size_t OFF_YG    = 432 * MiB;
constexpr size_t OFF_EIDX  = OFF_HGS;
constexpr size_t OFF_GATE  = OFF_HGS + 16 * MiB;
constexpr size_t WS_END    = 464 * MiB;

constexpr int LDS_BYTES = 139264;

struct Params {
    const float* in[26];
    float* out;
    unsigned char* ws;
};

__device__ __forceinline__ bf16_t f2bf(float f) {
    unsigned u = __float_as_uint(f);
    u += 0x7fffu + ((u >> 16) & 1u);
    return (bf16_t)(u >> 16);
}
__device__ __forceinline__ float bf2f(bf16_t h) { return __uint_as_float(((unsigned)h) << 16); }
__device__ __forceinline__ unsigned pack2(float lo, float hi) { return (unsigned)f2bf(lo) | ((unsigned)f2bf(hi) << 16); }
__device__ __forceinline__ float bflo(unsigned u) { return __uint_as_float(u << 16); }
__device__ __forceinline__ float bfhi(unsigned u) { return __uint_as_float(u & 0xffff0000u); }
__device__ __forceinline__ float sigmoidf_(float x) { return 1.0f / (1.0f + expf(-x)); }
__device__ __forceinline__ float siluf_(float x) { return x / (1.0f + expf(-x)); }
__device__ __forceinline__ float geluf_(float x) { return 0.5f * x * (1.0f + erff(x * 0.70710678118654752f)); }
__device__ __forceinline__ float wave_sum(float v) {
#pragma unroll
    for (int m = 32; m >= 1; m >>= 1) v += __shfl_xor(v, m, 64);
    return v;
}

__device__ void pack_B(const float* __restrict__ W, bf16_t* __restrict__ Wp, int K, int N, int gtid, int GT) {
    const int KT = K / 32;
    const int ngrp = KT * (N / 16) * 64;
    for (int grp = gtid; grp < ngrp; grp += GT) {
        const int l = grp & 63, tile = grp >> 6;
        const int kt = tile % KT, nt = tile / KT;
        const int k0 = kt * 32 + 8 * (l >> 4), n = nt * 16 + (l & 15);
        unsigned o[4];
#pragma unroll
        for (int j = 0; j < 4; ++j) o[j] = pack2(W[(size_t)(k0 + 2 * j) * N + n], W[(size_t)(k0 + 2 * j + 1) * N + n]);
        *(uint4*)(Wp + (size_t)grp * 8) = make_uint4(o[0], o[1], o[2], o[3]);
    }
}
__device__ void pack_BT(const float* __restrict__ Wt, bf16_t* __restrict__ Wp, int K, int N, int gtid, int GT) {
    const int KT = K / 32;
    const int ngrp = KT * (N / 16) * 64;
    for (int grp = gtid; grp < ngrp; grp += GT) {
        const int l = grp & 63, tile = grp >> 6;
        const int kt = tile % KT, nt = tile / KT;
        const int k0 = kt * 32 + 8 * (l >> 4), n = nt * 16 + (l & 15);
        const float* s = Wt + (size_t)n * K + k0;
        unsigned o[4];
#pragma unroll
        for (int j = 0; j < 4; ++j) o[j] = pack2(s[2 * j], s[2 * j + 1]);
        *(uint4*)(Wp + (size_t)grp * 8) = make_uint4(o[0], o[1], o[2], o[3]);
    }
}
__device__ void cvt_table(const float* __restrict__ src, bf16_t* __restrict__ dst, size_t n, int gtid, int GT) {
    const size_t ng = n / 8;
    for (size_t g = gtid; g < ng; g += GT) {
        const float4 a = ((const float4*)src)[2 * g], b = ((const float4*)src)[2 * g + 1];
        *(uint4*)(dst + g * 8) = make_uint4(pack2(a.x, a.y), pack2(a.z, a.w), pack2(b.x, b.y), pack2(b.z, b.w));
    }
}

__device__ void phase_prep(const Params& p, unsigned char* lds) {
    const int tid = threadIdx.x, bid = blockIdx.x, nb = gridDim.x;
    const int lane = tid & 63, wave = tid >> 6;
    const int gtid = bid * NT + tid, GT = nb * NT;
    unsigned char* ws = p.ws;
    {
        const float* c = p.in[1]; const float* aw = p.in[2]; const float* ab = p.in[3];
        float* mod = (float*)(ws + OFF_MOD);
        float* red = (float*)lds;
        for (int item = bid; item < 96; item += nb) {
            const int col = item * 64 + lane;
            float a0 = 0.f, a1 = 0.f;
            for (int k = wave * 128; k < wave * 128 + 128; ++k) {
                const float w = aw[(size_t)k * 6144 + col];
                a0 += siluf_(c[k]) * w; a1 += siluf_(c[1024 + k]) * w;
            }
            red[(wave * 2 + 0) * 64 + lane] = a0; red[(wave * 2 + 1) * 64 + lane] = a1;
            __syncthreads();
            if (tid < 128) {
                const int b = tid >> 6, l = tid & 63;
                float s = 0.f;
                for (int w = 0; w < NWAVE; ++w) s += red[(w * 2 + b) * 64 + l];
                mod[b * 6144 + item * 64 + l] = s + ab[item * 64 + l];
            }
            __syncthreads();
        }
    }
    {
        const float* lbin = p.in[8]; float* lb = (float*)(ws + OFF_LB);
        for (int i = gtid; i < 512; i += GT) {
            const float a = lbin[i], b = lbin[512 + i], m = fmaxf(a, b);
            const float ea = expf(a - m), eb = expf(b - m);
            lb[i] = ea / (ea + eb);
        }
    }
    {
        const float* are = p.in[10]; const float* aim = p.in[11]; const float* ldt = p.in[12];
        const float* bre = p.in[13]; const float* bim = p.in[14];
        float* AB = (float*)(ws + OFF_S5AB); float* BBR = (float*)(ws + OFF_S5BB); float* BBI = BBR + 32 * 64 * 16;
        for (int i = gtid; i < 2048; i += GT) {
            const int g = i >> 6;
            const double ar = are[i], ai = aim[i], dt = exp((double)ldt[g]);
            const double mag = exp(ar * dt), abr = mag * cos(ai * dt), abi = mag * sin(ai * dt);
            const double den = ar * ar + ai * ai, nr = abr - 1.0, ni = abi;
            const double cr = (nr * ar + ni * ai) / den, ci = (ni * ar - nr * ai) / den;
            const double magL = exp(ar * dt * (double)S5_SEG);
            AB[i] = (float)abr; AB[2048 + i] = (float)abi;
            AB[4096 + i] = (float)(magL * cos(ai * dt * (double)S5_SEG)); AB[6144 + i] = (float)(magL * sin(ai * dt * (double)S5_SEG));
            for (int h = 0; h < 16; ++h) {
                const double br = bre[i * 16 + h], bi = bim[i * 16 + h];
                BBR[i * 16 + h] = (float)(cr * br - ci * bi);
                BBI[i * 16 + h] = (float)(cr * bi + ci * br);
            }
        }
    }
    pack_B(p.in[6], (bf16_t*)(ws + OFF_WIN), 1024, 2560, gtid, GT);
    pack_B(p.in[7], (bf16_t*)(ws + OFF_WOUT), 1024, 1024, gtid, GT);
    pack_B(p.in[18], (bf16_t*)(ws + OFF_WGLU), 512, 512, gtid, GT);
    pack_B(p.in[20], (bf16_t*)(ws + OFF_WQ), 1024, 2048, gtid, GT);
    pack_BT(p.in[21], (bf16_t*)(ws + OFF_KEYS), 128, 128, gtid, GT);
    pack_BT(p.in[22], (bf16_t*)(ws + OFF_KEYS) + 128 * 128, 128, 128, gtid, GT);
    cvt_table(p.in[23], (bf16_t*)(ws + OFF_UT), (size_t)16384 * 1024, gtid, GT);
    cvt_table(p.in[24], (bf16_t*)(ws + OFF_VT), (size_t)16384 * 1024, gtid, GT);
}

__device__ void phase_norm(const Params& p, const float* __restrict__ src, const float* __restrict__ nw, int sh_off, int sc_off, bf16_t* __restrict__ dst) {
    const int tid = threadIdx.x, lane = tid & 63, wave = tid >> 6;
    const int gw = blockIdx.x * NWAVE + wave, GW = gridDim.x * NWAVE;
    const float* mod = (const float*)(p.ws + OFF_MOD);
    for (int b = 0; b < BATCH; ++b) {
        float4 fa[4], fs[4];
#pragma unroll
        for (int j = 0; j < 4; ++j) {
            const int c4 = j * 64 + lane;
            const float4 w = ((const float4*)nw)[c4];
            const float4 sc = ((const float4*)(mod + b * 6144 + sc_off))[c4];
            fs[j] = ((const float4*)(mod + b * 6144 + sh_off))[c4];
            fa[j] = make_float4(w.x * (1.f + sc.x), w.y * (1.f + sc.y), w.z * (1.f + sc.z), w.w * (1.f + sc.w));
        }
        for (int r = gw; r < SEQ; r += GW) {
            const size_t row = (size_t)b * SEQ + r;
            const float4* xr = (const float4*)(src + row * D);
            float4 v[4];
            float ss = 0.f;
#pragma unroll
            for (int j = 0; j < 4; ++j) { v[j] = xr[j * 64 + lane]; ss += v[j].x * v[j].x + v[j].y * v[j].y + v[j].z * v[j].z + v[j].w * v[j].w; }
            ss = wave_sum(ss);
            const float rstd = rsqrtf(ss * (1.0f / D) + EPS);
#pragma unroll
            for (int j = 0; j < 4; ++j) {
                const float o0 = v[j].x * rstd * fa[j].x + fs[j].x, o1 = v[j].y * rstd * fa[j].y + fs[j].y;
                const float o2 = v[j].z * rstd * fa[j].z + fs[j].z, o3 = v[j].w * rstd * fa[j].w + fs[j].w;
                *(uint2*)(dst + row * D + (size_t)(j * 64 + lane) * 4) = make_uint2(pack2(o0, o1), pack2(o2, o3));
            }
        }
    }
}

template <class Epi>
__device__ __forceinline__ void gemm_bf16(const bf16_t* __restrict__ A, int lda, const bf16_t* __restrict__ Wp, int M, int N, int K, Epi epi) {
    const int tid = threadIdx.x, lane = tid & 63, wave = tid >> 6;
    const int wm = wave >> 1, wn = wave & 1;
    const int KT = K / 32;
    const int tiles_n = N / 128, tiles = (M / 128) * tiles_n;
    for (int tile = blockIdx.x; tile < tiles; tile += gridDim.x) {
        const int tm = tile / tiles_n, tn = tile % tiles_n;
        const int m0 = tm * 128 + wm * 32, n0 = tn * 128 + wn * 64;
        f32x4 acc[2][4];
#pragma unroll
        for (int i = 0; i < 2; ++i)
#pragma unroll
            for (int j = 0; j < 4; ++j) acc[i][j] = (f32x4){0.f, 0.f, 0.f, 0.f};
        const bf16_t* a0p = A + (size_t)(m0 + (lane & 15)) * lda + (lane >> 4) * 8;
        const bf16_t* a1p = a0p + (size_t)16 * lda;
        const bf16_t* bp = Wp + ((size_t)(n0 / 16) * KT * 64 + lane) * 8;
#pragma unroll 2
        for (int kt = 0; kt < KT; ++kt) {
            const bf16x8 a0 = *(const bf16x8*)(a0p + kt * 32);
            const bf16x8 a1 = *(const bf16x8*)(a1p + kt * 32);
            bf16x8 b[4];
#pragma unroll
            for (int j = 0; j < 4; ++j) b[j] = *(const bf16x8*)(bp + ((size_t)j * KT + kt) * 512);
#pragma unroll
            for (int j = 0; j < 4; ++j) {
                acc[0][j] = __builtin_amdgcn_mfma_f32_16x16x32_bf16(a0, b[j], acc[0][j], 0, 0, 0);
                acc[1][j] = __builtin_amdgcn_mfma_f32_16x16x32_bf16(a1, b[j], acc[1][j], 0, 0, 0);
            }
        }
#pragma unroll
        for (int i = 0; i < 2; ++i)
#pragma unroll
            for (int j = 0; j < 4; ++j)
#pragma unroll
                for (int r = 0; r < 4; ++r) epi(m0 + i * 16 + 4 * (lane >> 4) + r, n0 + j * 16 + (lane & 15), acc[i][j][r]);
    }
}
struct EpiStoreBf16 {
    bf16_t* C; int ldc;
    __device__ __forceinline__ void operator()(int row, int col, float v) const { C[(size_t)row * ldc + col] = f2bf(v); }
};
struct EpiGlu {
    const bf16_t* YG; const float* bias; bf16_t* OC;
    __device__ __forceinline__ void operator()(int row, int col, float v) const {
        const float y = bf2f(YG[(size_t)row * 512 + col]);
        OC[(size_t)row * 1024 + 512 + col] = f2bf(y * sigmoidf_(v + bias[col]));
    }
};
struct EpiOut {
    const float* x; const float* mod; float* out;
    __device__ __forceinline__ void operator()(int row, int col, float v) const {
        const int b = row >> 14;
        out[(size_t)row * D + col] = x[(size_t)row * D + col] + mod[b * 6144 + 2048 + col] * v;
    }
};

constexpr int LS = 136;
__device__ __forceinline__ void hg_prep(const Params& p, float* R0, float* R1, int tok0, int h) {
    const int tid = threadIdx.x;
    const bf16_t* PROJ = (const bf16_t*)(p.ws + OFF_PROJ);
    const float* lb = (const float*)(p.ws + OFF_LB);
    for (int e = tid; e < 64 * 128; e += NT) {
        const int t = e >> 7, k = e & 127;
        const float z = bf2f(PROJ[(size_t)(tok0 + t) * INW + 512 + h * 128 + k]);
        const float lbv = lb[h * 128 + k];
        const float kk = (1.f - lbv) * sigmoidf_(-z);
        R0[t * LS + k] = logf(1.f - kk);
        R1[t * LS + k] = kk;
    }
    __syncthreads();
    if (tid < 128) {
        float s = 0.f;
        for (int t = 0; t < 64; ++t) { s += R0[t * LS + tid]; R0[t * LS + tid] = s; }
    }
    __syncthreads();
}

__device__ void phase_hg1(const Params& p, unsigned char* lds) {
    const int tid = threadIdx.x;
    float* R0 = (float*)lds; float* R1 = R0 + 64 * LS; float* R3 = R0 + 3 * 64 * LS;
    const bf16_t* PROJ = (const bf16_t*)(p.ws + OFF_PROJ);
    bf16_t* HGS = (bf16_t*)(p.ws + OFF_HGS);
    float* DEC = (float*)(p.ws + OFF_HGDEC);
    const int ty = tid >> 4, tx = tid & 15;
    for (int unit = blockIdx.x; unit < 2048; unit += gridDim.x) {
        const int c = unit & 255, h = (unit >> 8) & 3, b = unit >> 10;
        const int tok0 = b * SEQ + c * 64;
        hg_prep(p, R0, R1, tok0, h);
        for (int e = tid; e < 64 * 128; e += NT) {
            const int t = e >> 7, k = e & 127;
            R1[t * LS + k] *= expf(R0[63 * LS + k] - R0[t * LS + k]);
            R3[t * LS + k] = bf2f(PROJ[(size_t)(tok0 + t) * INW + 1024 + h * 128 + k]);
        }
        if (tid < 128) DEC[unit * 128 + tid] = expf(R0[63 * LS + tid]);
        __syncthreads();
        float acc[4][8];
#pragma unroll
        for (int i = 0; i < 4; ++i)
#pragma unroll
            for (int j = 0; j < 8; ++j) acc[i][j] = 0.f;
        for (int s = 0; s < 64; ++s) {
            float kv[4];
#pragma unroll
            for (int i = 0; i < 4; ++i) kv[i] = R1[s * LS + ty + 32 * i];
            const float4 v0 = *(const float4*)&R3[s * LS + 4 * tx], v1 = *(const float4*)&R3[s * LS + 64 + 4 * tx];
#pragma unroll
            for (int i = 0; i < 4; ++i) {
                acc[i][0] += kv[i] * v0.x; acc[i][1] += kv[i] * v0.y; acc[i][2] += kv[i] * v0.z; acc[i][3] += kv[i] * v0.w;
                acc[i][4] += kv[i] * v1.x; acc[i][5] += kv[i] * v1.y; acc[i][6] += kv[i] * v1.z; acc[i][7] += kv[i] * v1.w;
            }
        }
#pragma unroll
        for (int i = 0; i < 4; ++i) {
            bf16_t* d = HGS + ((size_t)unit * 128 + ty + 32 * i) * 128;
            *(uint2*)(d + 4 * tx) = make_uint2(pack2(acc[i][0], acc[i][1]), pack2(acc[i][2], acc[i][3]));
            *(uint2*)(d + 64 + 4 * tx) = make_uint2(pack2(acc[i][4], acc[i][5]), pack2(acc[i][6], acc[i][7]));
        }
        __syncthreads();
    }
}

__device__ void phase_hg2(const Params& p) {
    const int gtid = blockIdx.x * NT + threadIdx.x, GT = gridDim.x * NT;
    const bf16_t* __restrict__ HGS = (const bf16_t*)(p.ws + OFF_HGS);
    bf16_t* __restrict__ SST = (bf16_t*)(p.ws + OFF_H);
    const float* __restrict__ DEC = (const float*)(p.ws + OFF_HGDEC);
    for (int idx = gtid; idx < 8 * 16384; idx += GT) {
        const int bh = idx >> 14, kv = idx & 16383, k = kv >> 7;
        float s = 0.f;
#pragma unroll 8
        for (int c = 0; c < 256; ++c) {
            const size_t unit = (size_t)bh * 256 + c;
            const float loc = bf2f(HGS[unit * 16384 + kv]);
            const float d = DEC[unit * 128 + k];
            SST[unit * 16384 + kv] = f2bf(s);
            s = d * s + loc;
        }
    }
}

__device__ void phase_hg3(const Params& p, unsigned char* lds) {
    const int tid = threadIdx.x;
    float* R0 = (float*)lds; float* R1 = R0 + 64 * LS; float* R2 = R0 + 2 * 64 * LS; float* R3 = R0 + 3 * 64 * LS;
    bf16_t* S1 = (bf16_t*)R1;
    const bf16_t* PROJ = (const bf16_t*)(p.ws + OFF_PROJ);
    const bf16_t* SST = (const bf16_t*)(p.ws + OFF_H);
    bf16_t* OCAT = (bf16_t*)(p.ws + OFF_OCAT);
    const float* gnw = p.in[9];
    const int ty = tid >> 4, tx = tid & 15;
    for (int unit = blockIdx.x; unit < 2048; unit += gridDim.x) {
        const int c = unit & 255, h = (unit >> 8) & 3, b = unit >> 10;
        const int tok0 = b * SEQ + c * 64;
        hg_prep(p, R0, R1, tok0, h);
        for (int e = tid; e < 64 * 128; e += NT) {
            const int t = e >> 7, k = e & 127;
            const float bc = R0[t * LS + k];
            const size_t base = (size_t)(tok0 + t) * INW + h * 128 + k;
            const float q = bf2f(PROJ[base]);
            R2[t * LS + k] = siluf_(q) * 0.08838834764831845f * expf(bc);
            R1[t * LS + k] *= expf(-bc);
            R3[t * LS + k] = bf2f(PROJ[base + 1024]);
        }
        __syncthreads();
        float sc[2][4];
#pragma unroll
        for (int i = 0; i < 2; ++i)
#pragma unroll
            for (int j = 0; j < 4; ++j) sc[i][j] = 0.f;
        for (int k4 = 0; k4 < 32; ++k4) {
            float4 q[2], kk[4];
#pragma unroll
            for (int i = 0; i < 2; ++i) q[i] = *(const float4*)&R2[(ty + 32 * i) * LS + 4 * k4];
#pragma unroll
            for (int j = 0; j < 4; ++j) kk[j] = *(const float4*)&R1[(tx + 16 * j) * LS + 4 * k4];
#pragma unroll
            for (int i = 0; i < 2; ++i)
#pragma unroll
                for (int j = 0; j < 4; ++j) sc[i][j] += q[i].x * kk[j].x + q[i].y * kk[j].y + q[i].z * kk[j].z + q[i].w * kk[j].w;
        }
        __syncthreads();
#pragma unroll
        for (int i = 0; i < 2; ++i)
#pragma unroll
            for (int j = 0; j < 4; ++j) {
                const int t = ty + 32 * i, s = tx + 16 * j;
                R0[t * LS + s] = (s <= t) ? sc[i][j] : 0.f;
            }
        {
            const bf16_t* Sg = SST + (size_t)unit * 16384;
#pragma unroll
            for (int j = 0; j < 8; ++j) {
                const int ci = tid + NT * j, row = ci >> 5, c4 = ci & 31;
                *(uint2*)(S1 + row * LS + c4 * 4) = *(const uint2*)(Sg + row * 128 + c4 * 4);
            }
        }
        __syncthreads();
        float o[2][8];
#pragma unroll
        for (int i = 0; i < 2; ++i)
#pragma unroll
            for (int j = 0; j < 8; ++j) o[i][j] = 0.f;
        for (int k4 = 0; k4 < 32; ++k4) {
            float qa[2][4];
#pragma unroll
            for (int i = 0; i < 2; ++i) { const float4 t4 = *(const float4*)&R2[(ty + 32 * i) * LS + 4 * k4]; qa[i][0] = t4.x; qa[i][1] = t4.y; qa[i][2] = t4.z; qa[i][3] = t4.w; }
#pragma unroll
            for (int kk = 0; kk < 4; ++kk) {
                const uint2 s0 = *(const uint2*)(S1 + (4 * k4 + kk) * LS + 4 * tx), s1 = *(const uint2*)(S1 + (4 * k4 + kk) * LS + 64 + 4 * tx);
                const float sv[8] = {bflo(s0.x), bfhi(s0.x), bflo(s0.y), bfhi(s0.y), bflo(s1.x), bfhi(s1.x), bflo(s1.y), bfhi(s1.y)};
#pragma unroll
                for (int i = 0; i < 2; ++i)
#pragma unroll
                    for (int e = 0; e < 8; ++e) o[i][e] += qa[i][kk] * sv[e];
            }
        }
        for (int s4 = 0; s4 < 16; ++s4) {
            float aa[2][4];
#pragma unroll
            for (int i = 0; i < 2; ++i) { const float4 t4 = *(const float4*)&R0[(ty + 32 * i) * LS + 4 * s4]; aa[i][0] = t4.x; aa[i][1] = t4.y; aa[i][2] = t4.z; aa[i][3] = t4.w; }
#pragma unroll
            for (int ss = 0; ss < 4; ++ss) {
                const float4 v0 = *(const float4*)&R3[(4 * s4 + ss) * LS + 4 * tx], v1 = *(const float4*)&R3[(4 * s4 + ss) * LS + 64 + 4 * tx];
                const float vv[8] = {v0.x, v0.y, v0.z, v0.w, v1.x, v1.y, v1.z, v1.w};
#pragma unroll
                for (int i = 0; i < 2; ++i)
#pragma unroll
                    for (int e = 0; e < 8; ++e) o[i][e] += aa[i][ss] * vv[e];
            }
        }
#pragma unroll
        for (int i = 0; i < 2; ++i) {
            float ss = 0.f;
#pragma unroll
            for (int e = 0; e < 8; ++e) ss += o[i][e] * o[i][e];
            ss += __shfl_xor(ss, 8, 64); ss += __shfl_xor(ss, 4, 64); ss += __shfl_xor(ss, 2, 64); ss += __shfl_xor(ss, 1, 64);
            const float rstd = rsqrtf(ss * (1.0f / 128.0f) + EPS);
            const int t = ty + 32 * i;
#pragma unroll
            for (int j = 0; j < 2; ++j) {
                const int v = 4 * tx + 64 * j;
                const uint2 gq = *(const uint2*)(PROJ + (size_t)(tok0 + t) * INW + 1536 + h * 128 + v);
                const float4 gw = *(const float4*)(gnw + v);
                const float r0 = o[i][4 * j + 0] * rstd * gw.x * siluf_(bflo(gq.x));
                const float r1 = o[i][4 * j + 1] * rstd * gw.y * siluf_(bfhi(gq.x));
                const float r2 = o[i][4 * j + 2] * rstd * gw.z * siluf_(bflo(gq.y));
                const float r3 = o[i][4 * j + 3] * rstd * gw.w * siluf_(bfhi(gq.y));
                *(uint2*)(OCAT + (size_t)(tok0 + t) * 1024 + h * 128 + v) = make_uint2(pack2(r0, r1), pack2(r2, r3));
            }
        }
        __syncthreads();
    }
}

template <bool FINAL>
__device__ void phase_s5_scan(const Params& p, unsigned char* lds) {
    const int tid = threadIdx.x, lane = tid & 63, wave = tid >> 6;
    float* U = (float*)lds + wave * 1024;
    float* Y = (float*)(lds + 32768) + wave * 1024;
    const bf16_t* PROJ = (const bf16_t*)(p.ws + OFF_PROJ);
    const float* AB = (const float*)(p.ws + OFF_S5AB);
    const float* BBR = (const float*)(p.ws + OFF_S5BB); const float* BBI = BBR + 32 * 64 * 16;
    float* END = (float*)(p.ws + OFF_S5END);
    const float* CAR = (const float*)(p.ws + OFF_S5CAR);
    bf16_t* YG = (bf16_t*)(p.ws + OFF_YG);
    const float* cre_g = p.in[15]; const float* cim_g = p.in[16]; const float* dsk = p.in[17];
    for (int item = blockIdx.x; item < 256; item += gridDim.x) {
        const int unit = item * NWAVE + wave;
        const int seg = unit & 31, g = (unit >> 5) & 31, b = unit >> 10;
        float bre[16], bim[16], cre[16], cim[16];
#pragma unroll
        for (int h = 0; h < 16; ++h) { bre[h] = BBR[(g * 64 + lane) * 16 + h]; bim[h] = BBI[(g * 64 + lane) * 16 + h]; }
        if (FINAL) {
#pragma unroll
            for (int h = 0; h < 16; ++h) { cre[h] = cre_g[(g * 16 + h) * 64 + lane]; cim[h] = cim_g[(g * 16 + h) * 64 + lane]; }
        }
        const float are = AB[g * 64 + lane], aim = AB[2048 + g * 64 + lane];
        float xr = 0.f, xi = 0.f;
        const size_t sidx = (((size_t)b * 32 + g) * 32 + seg) * 128 + lane * 2;
        if (FINAL) { xr = CAR[sidx]; xi = CAR[sidx + 1]; }
        for (int tile = 0; tile < S5_SEG / 64; ++tile) {
            const int tokbase = b * SEQ + seg * S5_SEG + tile * 64;
            {
                const uint4* up = (const uint4*)(PROJ + (size_t)(tokbase + lane) * INW + 2048 + g * 16);
                const uint4 ua = up[0], ub = up[1];
                float4* ud = (float4*)(U + lane * 16);
                ud[0] = make_float4(bflo(ua.x), bfhi(ua.x), bflo(ua.y), bfhi(ua.y));
                ud[1] = make_float4(bflo(ua.z), bfhi(ua.z), bflo(ua.w), bfhi(ua.w));
                ud[2] = make_float4(bflo(ub.x), bfhi(ub.x), bflo(ub.y), bfhi(ub.y));
                ud[3] = make_float4(bflo(ub.z), bfhi(ub.z), bflo(ub.w), bfhi(ub.w));
            }
            __syncthreads();
            for (int t = 0; t < 64; ++t) {
                const float4 u0 = *(const float4*)(U + t * 16), u1 = *(const float4*)(U + t * 16 + 4), u2 = *(const float4*)(U + t * 16 + 8), u3 = *(const float4*)(U + t * 16 + 12);
                const float uu[16] = {u0.x, u0.y, u0.z, u0.w, u1.x, u1.y, u1.z, u1.w, u2.x, u2.y, u2.z, u2.w, u3.x, u3.y, u3.z, u3.w};
                float bur = 0.f, bui = 0.f;
#pragma unroll
                for (int h = 0; h < 16; ++h) { bur += uu[h] * bre[h]; bui += uu[h] * bim[h]; }
                const float nxr = are * xr - aim * xi + bur;
                const float nxi = are * xi + aim * xr + bui;
                xr = nxr; xi = nxi;
                if (FINAL) {
                    float yv[16];
#pragma unroll
                    for (int h = 0; h < 16; ++h) yv[h] = xr * cre[h] - xi * cim[h];
                    float r8[8], r4[4], r2[2], r1;
                    const bool b5 = (lane & 32) != 0, b4 = (lane & 16) != 0, b3 = (lane & 8) != 0, b2 = (lane & 4) != 0;
#pragma unroll
                    for (int i = 0; i < 8; ++i) { const float keep = b5 ? yv[i + 8] : yv[i], send = b5 ? yv[i] : yv[i + 8]; r8[i] = keep + __shfl_xor(send, 32, 64); }
#pragma unroll
                    for (int i = 0; i < 4; ++i) { const float keep = b4 ? r8[i + 4] : r8[i], send = b4 ? r8[i] : r8[i + 4]; r4[i] = keep + __shfl_xor(send, 16, 64); }
#pragma unroll
                    for (int i = 0; i < 2; ++i) { const float keep = b3 ? r4[i + 2] : r4[i], send = b3 ? r4[i] : r4[i + 2]; r2[i] = keep + __shfl_xor(send, 8, 64); }
                    { const float keep = b2 ? r2[1] : r2[0], send = b2 ? r2[0] : r2[1]; r1 = keep + __shfl_xor(send, 4, 64); }
                    r1 += __shfl_xor(r1, 2, 64);
                    r1 += __shfl_xor(r1, 1, 64);
                    if ((lane & 3) == 0) Y[t * 16 + (lane >> 2)] = r1;
                }
            }
            __syncthreads();
            if (FINAL) {
                unsigned o[8];
#pragma unroll
                for (int h2 = 0; h2 < 8; ++h2) {
                    const float y0 = Y[lane * 16 + 2 * h2] + dsk[g * 16 + 2 * h2] * U[lane * 16 + 2 * h2];
                    const float y1 = Y[lane * 16 + 2 * h2 + 1] + dsk[g * 16 + 2 * h2 + 1] * U[lane * 16 + 2 * h2 + 1];
                    o[h2] = pack2(geluf_(y0), geluf_(y1));
                }
                uint4* yd = (uint4*)(YG + (size_t)(tokbase + lane) * 512 + g * 16);
                yd[0] = make_uint4(o[0], o[1], o[2], o[3]); yd[1] = make_uint4(o[4], o[5], o[6], o[7]);
                __syncthreads();
            }
        }
        if (!FINAL) { END[sidx] = xr; END[sidx + 1] = xi; }
    }
}
__device__ void phase_s5_carry(const Params& p) {
    const int gtid = blockIdx.x * NT + threadIdx.x, GT = gridDim.x * NT;
    const float* AB = (const float*)(p.ws + OFF_S5AB);
    const float* END = (const float*)(p.ws + OFF_S5END);
    float* CAR = (float*)(p.ws + OFF_S5CAR);
    for (int idx = gtid; idx < 4096; idx += GT) {
        const int pp = idx & 63, g = (idx >> 6) & 31, b = idx >> 11;
        const float ar = AB[4096 + g * 64 + pp], ai = AB[6144 + g * 64 + pp];
        float cr = 0.f, ci = 0.f;
        for (int seg = 0; seg < S5_NSEG; ++seg) {
            const size_t sidx = (((size_t)b * 32 + g) * 32 + seg) * 128 + pp * 2;
            CAR[sidx] = cr; CAR[sidx + 1] = ci;
            const float er = END[sidx], ei = END[sidx + 1];
            const float nr = ar * cr - ai * ci + er, ni = ar * ci + ai * cr + ei;
            cr = nr; ci = ni;
        }
    }
}

constexpr int SCS = 132;
__device__ void phase_topk(const Params& p, unsigned char* lds) {
    const int tid = threadIdx.x, lane = tid & 63, wave = tid >> 6;
    float* sc = (float*)lds + wave * (2 * 16 * SCS);
    const bf16_t* Q = (const bf16_t*)(p.ws + OFF_PROJ);
    const bf16_t* KP = (const bf16_t*)(p.ws + OFF_KEYS);
    int* EIDX = (int*)(p.ws + OFF_EIDX); float* GATE = (float*)(p.ws + OFF_GATE);
    const int h = wave;
    for (int tg = blockIdx.x; tg < NTOK / 16; tg += gridDim.x) {
        const int tok0 = tg * 16;
#pragma unroll
        for (int half = 0; half < 2; ++half) {
            f32x4 acc[8];
#pragma unroll
            for (int n = 0; n < 8; ++n) acc[n] = (f32x4){0.f, 0.f, 0.f, 0.f};
#pragma unroll
            for (int kt = 0; kt < 4; ++kt) {
                const bf16x8 a = *(const bf16x8*)(Q + (size_t)(tok0 + (lane & 15)) * 2048 + h * 256 + half * 128 + kt * 32 + (lane >> 4) * 8);
#pragma unroll
                for (int n = 0; n < 8; ++n) {
                    const bf16x8 bb = *(const bf16x8*)(KP + (size_t)half * 16384 + ((size_t)(n * 4 + kt) * 64 + lane) * 8);
                    acc[n] = __builtin_amdgcn_mfma_f32_16x16x32_bf16(a, bb, acc[n], 0, 0, 0);
                }
            }
#pragma unroll
            for (int n = 0; n < 8; ++n)
#pragma unroll
                for (int r = 0; r < 4; ++r) sc[(half * 16 + 4 * (lane >> 4) + r) * SCS + n * 16 + (lane & 15)] = acc[n][r];
        }
        __syncthreads();
        if (lane < 32) {
            float* row = sc + lane * SCS;
            float tv[16]; int ti[16];
            float pv = INFINITY; int pi = -1;
#pragma unroll
            for (int r = 0; r < 16; ++r) {
                float best = -INFINITY; int bi = 0;
#pragma nounroll
                for (int i4 = 0; i4 < 32; ++i4) {
                    const float4 v4 = *(const float4*)(row + 4 * i4);
                    const float vv[4] = {v4.x, v4.y, v4.z, v4.w};
#pragma unroll
                    for (int e = 0; e < 4; ++e) {
                        const int i = 4 * i4 + e; const float v = vv[e];
                        const bool elig = (v < pv) || (v == pv && i > pi);
                        if (elig && v > best) { best = v; bi = i; }
                    }
                }
                tv[r] = best; ti[r] = bi; pv = best; pi = bi;
            }
#pragma unroll
            for (int r = 0; r < 16; ++r) { row[r] = tv[r]; row[16 + r] = __int_as_float(ti[r]); }
        }
        __syncthreads();
        if (lane < 16) {
            float* r1 = sc + lane * SCS; float* r2 = sc + (16 + lane) * SCS;
            {
                int ci = 32;
#pragma nounroll
                for (int a = 0; a < 16; ++a) {
                    const float va = r1[a]; const int ia = __float_as_int(r1[16 + a]) * 128;
                    const int nbb = 16 / (a + 1);
#pragma nounroll
                    for (int b2 = 0; b2 < nbb; ++b2, ++ci) { r1[ci] = va + r2[b2]; r2[ci] = __int_as_float(ia + __float_as_int(r2[16 + b2])); }
                }
            }
            float sum = 0.f, mx = 0.f;
#pragma nounroll
            for (int r = 0; r < 16; ++r) {
                float best = -INFINITY; int bc = 32;
#pragma nounroll
                for (int ci = 32; ci < 82; ++ci) { const float v = r1[ci]; if (v > best) { best = v; bc = ci; } }
                r1[bc] = -INFINITY;
                if (r == 0) mx = best;
                const float ex = expf(best - mx);
                sum += ex;
                r1[84 + r] = ex; r1[100 + r] = r2[bc];
            }
            const float inv = 1.0f / sum;
            const size_t o = ((size_t)(tok0 + lane) * 8 + h) * 16;
#pragma unroll
            for (int r = 0; r < 16; r += 4) {
                *(int4*)(EIDX + o + r) = make_int4(__float_as_int(r1[100 + r]), __float_as_int(r1[101 + r]), __float_as_int(r1[102 + r]), __float_as_int(r1[103 + r]));
                *(float4*)(GATE + o + r) = make_float4(r1[84 + r] * inv, r1[85 + r] * inv, r1[86 + r] * inv, r1[87 + r] * inv);
            }
        }
        __syncthreads();
    }
}

__device__ void phase_peer(const Params& p) {
    const int tid = threadIdx.x, lane = tid & 63, wave = tid >> 6;
    const int gw = blockIdx.x * NWAVE + wave, GW = gridDim.x * NWAVE;
    const bf16_t* H2 = (const bf16_t*)(p.ws + OFF_H);
    const bf16_t* UT = (const bf16_t*)(p.ws + OFF_UT); const bf16_t* VT = (const bf16_t*)(p.ws + OFF_VT);
    const int* EIDX = (const int*)(p.ws + OFF_EIDX); const float* GATE = (const float*)(p.ws + OFF_GATE);
    const float* mod = (const float*)(p.ws + OFF_MOD);
    const float* fnw = p.in[25];
    float* out = p.out;
    for (int tok = gw; tok < NTOK; tok += GW) {
        const uint4 hA = *(const uint4*)(H2 + (size_t)tok * D + lane * 8), hB = *(const uint4*)(H2 + (size_t)tok * D + 512 + lane * 8);
        const unsigned hq[8] = {hA.x, hA.y, hA.z, hA.w, hB.x, hB.y, hB.z, hB.w};
        float acc[16];
#pragma unroll
        for (int i = 0; i < 16; ++i) acc[i] = 0.f;
        const int e0 = EIDX[(size_t)tok * 128 + lane], e1 = EIDX[(size_t)tok * 128 + 64 + lane];
        const float g0 = GATE[(size_t)tok * 128 + lane], g1 = GATE[(size_t)tok * 128 + 64 + lane];
        for (int j0 = 0; j0 < 128; j0 += 4) {
            uint4 uA[4], uB[4], vA[4], vB[4]; float gt[4];
#pragma unroll
            for (int jj = 0; jj < 4; ++jj) {
                const int j = j0 + jj;
                const int e = __shfl((j < 64) ? e0 : e1, j & 63, 64);
                gt[jj] = __shfl((j < 64) ? g0 : g1, j & 63, 64);
                const bf16_t* ur = UT + (size_t)e * D; const bf16_t* vr = VT + (size_t)e * D;
                uA[jj] = *(const uint4*)(ur + lane * 8); uB[jj] = *(const uint4*)(ur + 512 + lane * 8);
                vA[jj] = *(const uint4*)(vr + lane * 8); vB[jj] = *(const uint4*)(vr + 512 + lane * 8);
            }
#pragma unroll
            for (int jj = 0; jj < 4; ++jj) {
                const unsigned uq[8] = {uA[jj].x, uA[jj].y, uA[jj].z, uA[jj].w, uB[jj].x, uB[jj].y, uB[jj].z, uB[jj].w};
                float d = 0.f;
#pragma unroll
                for (int i = 0; i < 8; ++i) d = __builtin_amdgcn_fdot2_f32_bf16(__builtin_bit_cast(bf2_t, uq[i]), __builtin_bit_cast(bf2_t, hq[i]), d, false);
                d = wave_sum(d);
                const float w = gt[jj] * geluf_(d);
                const unsigned vq[8] = {vA[jj].x, vA[jj].y, vA[jj].z, vA[jj].w, vB[jj].x, vB[jj].y, vB[jj].z, vB[jj].w};
#pragma unroll
                for (int i = 0; i < 8; ++i) { acc[2 * i] += w * bflo(vq[i]); acc[2 * i + 1] += w * bfhi(vq[i]); }
            }
        }
        const int b = tok >> 14;
        float* xrow = out + (size_t)tok * D;
        const float* g2 = mod + b * 6144 + 5120;
        float xo[16]; float ss = 0.f;
#pragma unroll
        for (int q = 0; q < 4; ++q) {
            const int col = (q >> 1) * 512 + lane * 8 + (q & 1) * 4;
            const float4 xv = *(const float4*)(xrow + col), gv = *(const float4*)(g2 + col);
            xo[4 * q + 0] = xv.x + gv.x * acc[4 * q + 0]; xo[4 * q + 1] = xv.y + gv.y * acc[4 * q + 1];
            xo[4 * q + 2] = xv.z + gv.z * acc[4 * q + 2]; xo[4 * q + 3] = xv.w + gv.w * acc[4 * q + 3];
#pragma unroll
            for (int e = 0; e < 4; ++e) ss += xo[4 * q + e] * xo[4 * q + e];
        }
        ss = wave_sum(ss);
        const float rstd = rsqrtf(ss * (1.0f / D) + EPS);
#pragma unroll
        for (int q = 0; q < 4; ++q) {
            const int col = (q >> 1) * 512 + lane * 8 + (q & 1) * 4;
            const float4 wv = *(const float4*)(fnw + col);
            *(float4*)(xrow + col) = make_float4(xo[4 * q] * rstd * wv.x, xo[4 * q + 1] * rstd * wv.y, xo[4 * q + 2] * rstd * wv.z, xo[4 * q + 3] * rstd * wv.w);
        }
    }
}

constexpr int N_PHASES = 12;
template <int PH>
__device__ __forceinline__ void run_phase(const Params& p, unsigned char* lds) {
    unsigned char* ws = p.ws;
    if (PH == 0) phase_prep(p, lds);
    if (PH == 1) phase_norm(p, p.in[0], p.in[4], 0, 1024, (bf16_t*)(ws + OFF_H));
    if (PH == 2) gemm_bf16((const bf16_t*)(ws + OFF_H), D, (const bf16_t*)(ws + OFF_WIN), NTOK, INW, D, EpiStoreBf16{(bf16_t*)(ws + OFF_PROJ), INW});
    if (PH == 3) { phase_hg1(p, lds); phase_s5_scan<false>(p, lds); }
    if (PH == 4) { phase_hg2(p); phase_s5_carry(p); }
    if (PH == 5) { phase_hg3(p, lds); phase_s5_scan<true>(p, lds); }
    if (PH == 6) gemm_bf16((const bf16_t*)(ws + OFF_YG), 512, (const bf16_t*)(ws + OFF_WGLU), NTOK, 512, 512, EpiGlu{(const bf16_t*)(ws + OFF_YG), p.in[19], (bf16_t*)(ws + OFF_OCAT)});
    if (PH == 7) gemm_bf16((const bf16_t*)(ws + OFF_OCAT), D, (const bf16_t*)(ws + OFF_WOUT), NTOK, D, D, EpiOut{p.in[0], (const float*)(ws + OFF_MOD), p.out});
    if (PH == 8) phase_norm(p, p.out, p.in[5], 3072, 4096, (bf16_t*)(ws + OFF_H));
    if (PH == 9) gemm_bf16((const bf16_t*)(ws + OFF_H), D, (const bf16_t*)(ws + OFF_WQ), NTOK, 2048, D, EpiStoreBf16{(bf16_t*)(ws + OFF_PROJ), 2048});
    if (PH == 10) phase_topk(p, lds);
    if (PH == 11) phase_peer(p);
}

template <int PH>
__global__ void __launch_bounds__(NT) k_phase(Params p) {
    __shared__ __attribute__((aligned(16))) unsigned char lds[LDS_BYTES];
    run_phase<PH>(p, lds);
}

#if ONE_LAUNCH
__global__ void __launch_bounds__(NT) k_mega(Params p) {
    __shared__ __attribute__((aligned(16))) unsigned char lds[LDS_BYTES];
    cg::grid_group grid = cg::this_grid();
    run_phase<0>(p, lds); grid.sync();
    run_phase<1>(p, lds); grid.sync();
    run_phase<2>(p, lds); grid.sync();
    run_phase<3>(p, lds); grid.sync();
    run_phase<4>(p, lds); grid.sync();
    run_phase<5>(p, lds); grid.sync();
    run_phase<6>(p, lds); grid.sync();
    run_phase<7>(p, lds); grid.sync();
    run_phase<8>(p, lds); grid.sync();
    run_phase<9>(p, lds); grid.sync();
    run_phase<10>(p, lds); grid.sync();
    run_phase<11>(p, lds);
}

#endif

template <int PH>
static void launch_phase(const Params& p, int grid, hipStream_t stream) {
    hipLaunchKernelGGL(k_phase<PH>, dim3(grid), dim3(NT), 0, stream, p);
}

extern "C" void kernel_launch(void* const* d_in, const int* in_sizes, int n_in, void* d_out, int out_size, void* d_ws, size_t ws_size, hipStream_t stream) {
    if (n_in != 26 || ws_size < WS_END) { fprintf(stderr, "kernel_launch: unexpected inputs (n_in %d, ws %zu)\n", n_in, ws_size); return; }
    Params p{};
    for (int i = 0; i < 26; ++i) p.in[i] = (const float*)d_in[i];
    p.out = (float*)d_out; p.ws = (unsigned char*)d_ws;
#if ONE_LAUNCH
    static int grid = 0;
    if (!grid) {
        int dev = 0, cus = 0, per_cu = 0;
        hipGetDevice(&dev);
        hipDeviceGetAttribute(&cus, hipDeviceAttributeMultiprocessorCount, dev);
        hipOccupancyMaxActiveBlocksPerMultiprocessor(&per_cu, k_mega, NT, 0);
        if (per_cu < 1) per_cu = 1;
        grid = cus;
    }
    void* args[] = {&p};
    hipError_t e = hipLaunchCooperativeKernel((void*)k_mega, dim3(grid), dim3(NT), args, 0, stream);
    if (e != hipSuccess) fprintf(stderr, "cooperative launch failed: %s (grid %d)\n", hipGetErrorString(e), grid);
#else
    const int grid = 256;
    launch_phase<0>(p, grid, stream); launch_phase<1>(p, grid, stream); launch_phase<2>(p, grid, stream);
    launch_phase<3>(p, grid, stream); launch_phase<4>(p, grid, stream); launch_phase<5>(p, grid, stream);
    launch_phase<6>(p, grid, stream); launch_phase<7>(p, grid, stream); launch_phase<8>(p, grid, stream);
    launch_phase<9>(p, grid, stream); launch_phase<10>(p, grid, stream); launch_phase<11>(p, grid, stream);
#endif
}
```

```cpp
#include <hip/hip_runtime.h>
#include <hip/hip_cooperative_groups.h>
#include <stdint.h>
#include <stdio.h>
namespace cg = cooperative_groups;

#ifndef ONE_LAUNCH
#define ONE_LAUNCH 1
#endif

typedef unsigned short bf16_t;
typedef __attribute__((ext_vector_type(8))) short bf16x8;
typedef __attribute__((ext_vector_type(4))) float f32x4;
typedef __attribute__((ext_vector_type(2))) __bf16 bf2_t;

constexpr int D = 1024, BATCH = 2, SEQ = 16384, NTOK = BATCH * SEQ;
constexpr int DK = 128;
constexpr int INW = 2560;
constexpr int NT = 512;
constexpr int NWAVE = NT / 64;
constexpr float EPS = 1e-6f;
constexpr int S5_SEG = 512, S5_NSEG = SEQ / S5_SEG;

constexpr size_t MiB = 1024ull * 1024ull;
constexpr size_t OFF_CTL   = 0;
constexpr size_t OFF_MOD   = 64 * 1024;
constexpr size_t OFF_LB    = OFF_MOD + 48 * 1024;
constexpr size_t OFF_S5AB  = OFF_LB + 2048;
constexpr size_t OFF_S5BB  = OFF_S5AB + 32 * 1024;
constexpr size_t OFF_S5END = 1 * MiB;
constexpr size_t OFF_S5CAR = 2 * MiB;
constexpr size_t OFF_HGDEC = 3 * MiB;
constexpr size_t OFF_WIN   = 4 * MiB;
constexpr size_t OFF_WOUT  = 9 * MiB;
constexpr size_t OFF_WGLU  = 11 * MiB;
constexpr size_t OFF_KEYS  = 11 * MiB + 512 * 1024;
constexpr size_t OFF_WQ    = 12 * MiB;
constexpr size_t OFF_UT    = 16 * MiB;
constexpr size_t OFF_VT    = 48 * MiB;
constexpr size_t OFF_H     = 80 * MiB;
constexpr size_t OFF_PROJ  = 144 * MiB;
constexpr size_t OFF_OCAT  = 304 * MiB;
constexpr size_t OFF_HGS   = 368 * MiB;
constexpr size_t OFF_YG    = 432 * MiB;
constexpr size_t OFF_EIDX  = OFF_HGS;
constexpr size_t OFF_GATE  = OFF_HGS + 16 * MiB;
constexpr size_t WS_END    = 464 * MiB;

constexpr int LDS_BYTES = 139264;

struct Params {
    const float* in[26];
    float* out;
    unsigned char* ws;
};

__device__ __forceinline__ bf16_t f2bf(float f) {
    unsigned u = __float_as_uint(f);
    u += 0x7fffu + ((u >> 16) & 1u);
    return (bf16_t)(u >> 16);
}
__device__ __forceinline__ float bf2f(bf16_t h) { return __uint_as_float(((unsigned)h) << 16); }
__device__ __forceinline__ unsigned pack2(float lo, float hi) { return (unsigned)f2bf(lo) | ((unsigned)f2bf(hi) << 16); }
__device__ __forceinline__ float bflo(unsigned u) { return __uint_as_float(u << 16); }
__device__ __forceinline__ float bfhi(unsigned u) { return __uint_as_float(u & 0xffff0000u); }
__device__ __forceinline__ float sigmoidf_(float x) { return 1.0f / (1.0f + expf(-x)); }
__device__ __forceinline__ float siluf_(float x) { return x / (1.0f + expf(-x)); }
__device__ __forceinline__ float geluf_(float x) { return 0.5f * x * (1.0f + erff(x * 0.70710678118654752f)); }
__device__ __forceinline__ float wave_sum(float v) {
#pragma unroll
    for (int m = 32; m >= 1; m >>= 1) v += __shfl_xor(v, m, 64);
    return v;
}

__device__ void pack_B(const float* __restrict__ W, bf16_t* __restrict__ Wp, int K, int N, int gtid, int GT) {
    const int KT = K / 32;
    const int ngrp = KT * (N / 16) * 64;
    for (int grp = gtid; grp < ngrp; grp += GT) {
        const int l = grp & 63, tile = grp >> 6;
        const int kt = tile % KT, nt = tile / KT;
        const int k0 = kt * 32 + 8 * (l >> 4), n = nt * 16 + (l & 15);
        unsigned o[4];
#pragma unroll
        for (int j = 0; j < 4; ++j) o[j] = pack2(W[(size_t)(k0 + 2 * j) * N + n], W[(size_t)(k0 + 2 * j + 1) * N + n]);
        *(uint4*)(Wp + (size_t)grp * 8) = make_uint4(o[0], o[1], o[2], o[3]);
    }
}
__device__ void pack_BT(const float* __restrict__ Wt, bf16_t* __restrict__ Wp, int K, int N, int gtid, int GT) {
    const int KT = K / 32;
    const int ngrp = KT * (N / 16) * 64;
    for (int grp = gtid; grp < ngrp; grp += GT) {
        const int l = grp & 63, tile = grp >> 6;
        const int kt = tile % KT, nt = tile / KT;
        const int k0 = kt * 32 + 8 * (l >> 4), n = nt * 16 + (l & 15);
        const float* s = Wt + (size_t)n * K + k0;
        unsigned o[4];
#pragma unroll
        for (int j = 0; j < 4; ++j) o[j] = pack2(s[2 * j], s[2 * j + 1]);
        *(uint4*)(Wp + (size_t)grp * 8) = make_uint4(o[0], o[1], o[2], o[3]);
    }
}
__device__ void cvt_table(const float* __restrict__ src, bf16_t* __restrict__ dst, size_t n, int gtid, int GT) {
    const size_t ng = n / 8;
    for (size_t g = gtid; g < ng; g += GT) {
        const float4 a = ((const float4*)src)[2 * g], b = ((const float4*)src)[2 * g + 1];
        *(uint4*)(dst + g * 8) = make_uint4(pack2(a.x, a.y), pack2(a.z, a.w), pack2(b.x, b.y), pack2(b.z, b.w));
    }
}

__device__ void phase_prep(const Params& p, unsigned char* lds) {
    const int tid = threadIdx.x, bid = blockIdx.x, nb = gridDim.x;
    const int lane = tid & 63, wave = tid >> 6;
    const int gtid = bid * NT + tid, GT = nb * NT;
    unsigned char* ws = p.ws;
    {
        const float* c = p.in[1]; const float* aw = p.in[2]; const float* ab = p.in[3];
        float* mod = (float*)(ws + OFF_MOD);
        float* red = (float*)lds;
        for (int item = bid; item < 96; item += nb) {
            const int col = item * 64 + lane;
            float a0 = 0.f, a1 = 0.f;
            for (int k = wave * 128; k < wave * 128 + 128; ++k) {
                const float w = aw[(size_t)k * 6144 + col];
                a0 += siluf_(c[k]) * w; a1 += siluf_(c[1024 + k]) * w;
            }
            red[(wave * 2 + 0) * 64 + lane] = a0; red[(wave * 2 + 1) * 64 + lane] = a1;
            __syncthreads();
            if (tid < 128) {
                const int b = tid >> 6, l = tid & 63;
                float s = 0.f;
                for (int w = 0; w < NWAVE; ++w) s += red[(w * 2 + b) * 64 + l];
                mod[b * 6144 + item * 64 + l] = s + ab[item * 64 + l];
            }
            __syncthreads();
        }
    }
    {
        const float* lbin = p.in[8]; float* lb = (float*)(ws + OFF_LB);
        for (int i = gtid; i < 512; i += GT) {
            const float a = lbin[i], b = lbin[512 + i], m = fmaxf(a, b);
            const float ea = expf(a - m), eb = expf(b - m);
            lb[i] = ea / (ea + eb);
        }
    }
    {
        const float* are = p.in[10]; const float* aim = p.in[11]; const float* ldt = p.in[12];
        const float* bre = p.in[13]; const float* bim = p.in[14];
        float* AB = (float*)(ws + OFF_S5AB); float* BBR = (float*)(ws + OFF_S5BB); float* BBI = BBR + 32 * 64 * 16;
        for (int i = gtid; i < 2048; i += GT) {
            const int g = i >> 6;
            const double ar = are[i], ai = aim[i], dt = exp((double)ldt[g]);
            const double mag = exp(ar * dt), abr = mag * cos(ai * dt), abi = mag * sin(ai * dt);
            const double den = ar * ar + ai * ai, nr = abr - 1.0, ni = abi;
            const double cr = (nr * ar + ni * ai) / den, ci = (ni * ar - nr * ai) / den;
            const double magL = exp(ar * dt * (double)S5_SEG);
            AB[i] = (float)abr; AB[2048 + i] = (float)abi;
            AB[4096 + i] = (float)(magL * cos(ai * dt * (double)S5_SEG)); AB[6144 + i] = (float)(magL * sin(ai * dt * (double)S5_SEG));
            for (int h = 0; h < 16; ++h) {
                const double br = bre[i * 16 + h], bi = bim[i * 16 + h];
                BBR[i * 16 + h] = (float)(cr * br - ci * bi);
                BBI[i * 16 + h] = (float)(cr * bi + ci * br);
            }
        }
    }
    pack_B(p.in[6], (bf16_t*)(ws + OFF_WIN), 1024, 2560, gtid, GT);
    pack_B(p.in[7], (bf16_t*)(ws + OFF_WOUT), 1024, 1024, gtid, GT);
    pack_B(p.in[18], (bf16_t*)(ws + OFF_WGLU), 512, 512, gtid, GT);
    pack_B(p.in[20], (bf16_t*)(ws + OFF_WQ), 1024, 2048, gtid, GT);
    pack_BT(p.in[21], (bf16_t*)(ws + OFF_KEYS), 128, 128, gtid, GT);
    pack_BT(p.in[22], (bf16_t*)(ws + OFF_KEYS) + 128 * 128, 128, 128, gtid, GT);
    cvt_table(p.in[23], (bf16_t*)(ws + OFF_UT), (size_t)16384 * 1024, gtid, GT);
    cvt_table(p.in[24], (bf16_t*)(ws + OFF_VT), (size_t)16384 * 1024, gtid, GT);
}

__device__ void phase_norm(const Params& p, const float* __restrict__ src, const float* __restrict__ nw, int sh_off, int sc_off, bf16_t* __restrict__ dst) {
    const int tid = threadIdx.x, lane = tid & 63, wave = tid >> 6;
    const int gw = blockIdx.x * NWAVE + wave, GW = gridDim.x * NWAVE;
    const float* mod = (const float*)(p.ws + OFF_MOD);
    for (int b = 0; b < BATCH; ++b) {
        float4 fa[4], fs[4];
#pragma unroll
        for (int j = 0; j < 4; ++j) {
            const int c4 = j * 64 + lane;
            const float4 w = ((const float4*)nw)[c4];
            const float4 sc = ((const float4*)(mod + b * 6144 + sc_off))[c4];
            fs[j] = ((const float4*)(mod + b * 6144 + sh_off))[c4];
            fa[j] = make_float4(w.x * (1.f + sc.x), w.y * (1.f + sc.y), w.z * (1.f + sc.z), w.w * (1.f + sc.w));
        }
        for (int r = gw; r < SEQ; r += GW) {
            const size_t row = (size_t)b * SEQ + r;
            const float4* xr = (const float4*)(src + row * D);
            float4 v[4];
            float ss = 0.f;
#pragma unroll
            for (int j = 0; j < 4; ++j) { v[j] = xr[j * 64 + lane]; ss += v[j].x * v[j].x + v[j].y * v[j].y + v[j].z * v[j].z + v[j].w * v[j].w; }
            ss = wave_sum(ss);
            const float rstd = rsqrtf(ss * (1.0f / D) + EPS);
#pragma unroll
            for (int j = 0; j < 4; ++j) {
                const float o0 = v[j].x * rstd * fa[j].x + fs[j].x, o1 = v[j].y * rstd * fa[j].y + fs[j].y;
                const float o2 = v[j].z * rstd * fa[j].z + fs[j].z, o3 = v[j].w * rstd * fa[j].w + fs[j].w;
                *(uint2*)(dst + row * D + (size_t)(j * 64 + lane) * 4) = make_uint2(pack2(o0, o1), pack2(o2, o3));
            }
        }
    }
}

template <class Epi>
__device__ __forceinline__ void gemm_bf16(const bf16_t* __restrict__ A, int lda, const bf16_t* __restrict__ Wp, int M, int N, int K, Epi epi) {
    const int tid = threadIdx.x, lane = tid & 63, wave = tid >> 6;
    const int wm = wave >> 1, wn = wave & 1;
    const int KT = K / 32;
    const int tiles_n = N / 128, tiles = (M / 128) * tiles_n;
    for (int tile = blockIdx.x; tile < tiles; tile += gridDim.x) {
        const int tm = tile / tiles_n, tn = tile % tiles_n;
        const int m0 = tm * 128 + wm * 32, n0 = tn * 128 + wn * 64;
        f32x4 acc[2][4];
#pragma unroll
        for (int i = 0; i < 2; ++i)
#pragma unroll
            for (int j = 0; j < 4; ++j) acc[i][j] = (f32x4){0.f, 0.f, 0.f, 0.f};
        const bf16_t* a0p = A + (size_t)(m0 + (lane & 15)) * lda + (lane >> 4) * 8;
        const bf16_t* a1p = a0p + (size_t)16 * lda;
        const bf16_t* bp = Wp + ((size_t)(n0 / 16) * KT * 64 + lane) * 8;
#pragma unroll 2
        for (int kt = 0; kt < KT; ++kt) {
            const bf16x8 a0 = *(const bf16x8*)(a0p + kt * 32);
            const bf16x8 a1 = *(const bf16x8*)(a1p + kt * 32);
            bf16x8 b[4];
#pragma unroll
            for (int j = 0; j < 4; ++j) b[j] = *(const bf16x8*)(bp + ((size_t)j * KT + kt) * 512);
#pragma unroll
            for (int j = 0; j < 4; ++j) {
                acc[0][j] = __builtin_amdgcn_mfma_f32_16x16x32_bf16(a0, b[j], acc[0][j], 0, 0, 0);
                acc[1][j] = __builtin_amdgcn_mfma_f32_16x16x32_bf16(a1, b[j], acc[1][j], 0, 0, 0);
            }
        }
#pragma unroll
        for (int i = 0; i < 2; ++i)
#pragma unroll
            for (int j = 0; j < 4; ++j)
#pragma unroll
                for (int r = 0; r < 4; ++r) epi(m0 + i * 16 + 4 * (lane >> 4) + r, n0 + j * 16 + (lane & 15), acc[i][j][r]);
    }
}
struct EpiStoreBf16 {
    bf16_t* C; int ldc;
    __device__ __forceinline__ void operator()(int row, int col, float v) const { C[(size_t)row * ldc + col] = f2bf(v); }
};
struct EpiGlu {
    const bf16_t* YG; const float* bias; bf16_t* OC;
    __device__ __forceinline__ void operator()(int row, int col, float v) const {
        const float y = bf2f(YG[(size_t)row * 512 + col]);
        OC[(size_t)row * 1024 + 512 + col] = f2bf(y * sigmoidf_(v + bias[col]));
    }
};
struct EpiOut {
    const float* x; const float* mod; float* out;
    __device__ __forceinline__ void operator()(int row, int col, float v) const {
        const int b = row >> 14;
        out[(size_t)row * D + col] = x[(size_t)row * D + col] + mod[b * 6144 + 2048 + col] * v;
    }
};

constexpr int LS = 136;
__device__ __forceinline__ void hg_prep(const Params& p, float* R0, float* R1, int tok0, int h) {
    const int tid = threadIdx.x;
    const bf16_t* PROJ = (const bf16_t*)(p.ws + OFF_PROJ);
    const float* lb = (const float*)(p.ws + OFF_LB);
    for (int e = tid; e < 64 * 128; e += NT) {
        const int t = e >> 7, k = e & 127;
        const float z = bf2f(PROJ[(size_t)(tok0 + t) * INW + 512 + h * 128 + k]);
        const float lbv = lb[h * 128 + k];
        const float kk = (1.f - lbv) * sigmoidf_(-z);
        R0[t * LS + k] = logf(1.f - kk);
        R1[t * LS + k] = kk;
    }
    __syncthreads();
    if (tid < 128) {
        float s = 0.f;
        for (int t = 0; t < 64; ++t) { s += R0[t * LS + tid]; R0[t * LS + tid] = s; }
    }
    __syncthreads();
}

__device__ void phase_hg1(const Params& p, unsigned char* lds) {
    const int tid = threadIdx.x;
    float* R0 = (float*)lds; float* R1 = R0 + 64 * LS; float* R3 = R0 + 3 * 64 * LS;
    const bf16_t* PROJ = (const bf16_t*)(p.ws + OFF_PROJ);
    bf16_t* HGS = (bf16_t*)(p.ws + OFF_HGS);
    float* DEC = (float*)(p.ws + OFF_HGDEC);
    const int ty = tid >> 4, tx = tid & 15;
    for (int unit = blockIdx.x; unit < 2048; unit += gridDim.x) {
        const int c = unit & 255, h = (unit >> 8) & 3, b = unit >> 10;
        const int tok0 = b * SEQ + c * 64;
        hg_prep(p, R0, R1, tok0, h);
        for (int e = tid; e < 64 * 128; e += NT) {
            const int t = e >> 7, k = e & 127;
            R1[t * LS + k] *= expf(R0[63 * LS + k] - R0[t * LS + k]);
            R3[t * LS + k] = bf2f(PROJ[(size_t)(tok0 + t) * INW + 1024 + h * 128 + k]);
        }
        if (tid < 128) DEC[unit * 128 + tid] = expf(R0[63 * LS + tid]);
        __syncthreads();
        float acc[4][8];
#pragma unroll
        for (int i = 0; i < 4; ++i)
#pragma unroll
            for (int j = 0; j < 8; ++j) acc[i][j] = 0.f;
        for (int s = 0; s < 64; ++s) {
            float kv[4];
#pragma unroll
            for (int i = 0; i < 4; ++i) kv[i] = R1[s * LS + ty + 32 * i];
            const float4 v0 = *(const float4*)&R3[s * LS + 4 * tx], v1 = *(const float4*)&R3[s * LS + 64 + 4 * tx];
#pragma unroll
            for (int i = 0; i < 4; ++i) {
                acc[i][0] += kv[i] * v0.x; acc[i][1] += kv[i] * v0.y; acc[i][2] += kv[i] * v0.z; acc[i][3] += kv[i] * v0.w;
                acc[i][4] += kv[i] * v1.x; acc[i][5] += kv[i] * v1.y; acc[i][6] += kv[i] * v1.z; acc[i][7] += kv[i] * v1.w;
            }
        }
#pragma unroll
        for (int i = 0; i < 4; ++i) {
            bf16_t* d = HGS + ((size_t)unit * 128 + ty + 32 * i) * 128;
            *(uint2*)(d + 4 * tx) = make_uint2(pack2(acc[i][0], acc[i][1]), pack2(acc[i][2], acc[i][3]));
            *(uint2*)(d + 64 + 4 * tx) = make_uint2(pack2(acc[i][4], acc[i][5]), pack2(acc[i][6], acc[i][7]));
        }
        __syncthreads();
    }
}

__device__ void phase_hg2(const Params& p) {
    const int gtid = blockIdx.x * NT + threadIdx.x, GT = gridDim.x * NT;
    const bf16_t* __restrict__ HGS = (const bf16_t*)(p.ws + OFF_HGS);
    bf16_t* __restrict__ SST = (bf16_t*)(p.ws + OFF_H);
    const float* __restrict__ DEC = (const float*)(p.ws + OFF_HGDEC);
    for (int idx = gtid; idx < 8 * 16384; idx += GT) {
        const int bh = idx >> 14, kv = idx & 16383, k = kv >> 7;
        float s = 0.f;
#pragma unroll 8
        for (int c = 0; c < 256; ++c) {
            const size_t unit = (size_t)bh * 256 + c;
            const float loc = bf2f(HGS[unit * 16384 + kv]);
            const float d = DEC[unit * 128 + k];
            SST[unit * 16384 + kv] = f2bf(s);
            s = d * s + loc;
        }
    }
}

__device__ void phase_hg3(const Params& p, unsigned char* lds) {
    const int tid = threadIdx.x;
    float* R0 = (float*)lds; float* R1 = R0 + 64 * LS; float* R2 = R0 + 2 * 64 * LS; float* R3 = R0 + 3 * 64 * LS;
    bf16_t* S1 = (bf16_t*)R1;
    const bf16_t* PROJ = (const bf16_t*)(p.ws + OFF_PROJ);
    const bf16_t* SST = (const bf16_t*)(p.ws + OFF_H);
    bf16_t* OCAT = (bf16_t*)(p.ws + OFF_OCAT);
    const float* gnw = p.in[9];
    const int ty = tid >> 4, tx = tid & 15;
    for (int unit = blockIdx.x; unit < 2048; unit += gridDim.x) {
        const int c = unit & 255, h = (unit >> 8) & 3, b = unit >> 10;
        const int tok0 = b * SEQ + c * 64;
        hg_prep(p, R0, R1, tok0, h);
        for (int e = tid; e < 64 * 128; e += NT) {
            const int t = e >> 7, k = e & 127;
            const float bc = R0[t * LS + k];
            const size_t base = (size_t)(tok0 + t) * INW + h * 128 + k;
            const float q = bf2f(PROJ[base]);
            R2[t * LS + k] = siluf_(q) * 0.08838834764831845f * expf(bc);
            R1[t * LS + k] *= expf(-bc);
            R3[t * LS + k] = bf2f(PROJ[base + 1024]);
        }
        __syncthreads();
        float sc[2][4];
#pragma unroll
        for (int i = 0; i < 2; ++i)
#pragma unroll
            for (int j = 0; j < 4; ++j) sc[i][j] = 0.f;
        for (int k4 = 0; k4 < 32; ++k4) {
            float4 q[2], kk[4];
#pragma unroll
            for (int i = 0; i < 2; ++i) q[i] = *(const float4*)&R2[(ty + 32 * i) * LS + 4 * k4];
#pragma unroll
            for (int j = 0; j < 4; ++j) kk[j] = *(const float4*)&R1[(tx + 16 * j) * LS + 4 * k4];
#pragma unroll
            for (int i = 0; i < 2; ++i)
#pragma unroll
                for (int j = 0; j < 4; ++j) sc[i][j] += q[i].x * kk[j].x + q[i].y * kk[j].y + q[i].z * kk[j].z + q[i].w * kk[j].w;
        }
        __syncthreads();
#pragma unroll
        for (int i = 0; i < 2; ++i)
#pragma unroll
            for (int j = 0; j < 4; ++j) {
                const int t = ty + 32 * i, s = tx + 16 * j;
                R0[t * LS + s] = (s <= t) ? sc[i][j] : 0.f;
            }
        {
            const bf16_t* Sg = SST + (size_t)unit * 16384;
#pragma unroll
            for (int j = 0; j < 8; ++j) {
                const int ci = tid + NT * j, row = ci >> 5, c4 = ci & 31;
                *(uint2*)(S1 + row * LS + c4 * 4) = *(const uint2*)(Sg + row * 128 + c4 * 4);
            }
        }
        __syncthreads();
        float o[2][8];
#pragma unroll
        for (int i = 0; i < 2; ++i)
#pragma unroll
            for (int j = 0; j < 8; ++j) o[i][j] = 0.f;
        for (int k4 = 0; k4 < 32; ++k4) {
            float qa[2][4];
#pragma unroll
            for (int i = 0; i < 2; ++i) { const float4 t4 = *(const float4*)&R2[(ty + 32 * i) * LS + 4 * k4]; qa[i][0] = t4.x; qa[i][1] = t4.y; qa[i][2] = t4.z; qa[i][3] = t4.w; }
#pragma unroll
            for (int kk = 0; kk < 4; ++kk) {
                const uint2 s0 = *(const uint2*)(S1 + (4 * k4 + kk) * LS + 4 * tx), s1 = *(const uint2*)(S1 + (4 * k4 + kk) * LS + 64 + 4 * tx);
                const float sv[8] = {bflo(s0.x), bfhi(s0.x), bflo(s0.y), bfhi(s0.y), bflo(s1.x), bfhi(s1.x), bflo(s1.y), bfhi(s1.y)};
#pragma unroll
                for (int i = 0; i < 2; ++i)
#pragma unroll
                    for (int e = 0; e < 8; ++e) o[i][e] += qa[i][kk] * sv[e];
            }
        }
        for (int s4 = 0; s4 < 16; ++s4) {
            float aa[2][4];
#pragma unroll
            for (int i = 0; i < 2; ++i) { const float4 t4 = *(const float4*)&R0[(ty + 32 * i) * LS + 4 * s4]; aa[i][0] = t4.x; aa[i][1] = t4.y; aa[i][2] = t4.z; aa[i][3] = t4.w; }
#pragma unroll
            for (int ss = 0; ss < 4; ++ss) {
                const float4 v0 = *(const float4*)&R3[(4 * s4 + ss) * LS + 4 * tx], v1 = *(const float4*)&R3[(4 * s4 + ss) * LS + 64 + 4 * tx];
                const float vv[8] = {v0.x, v0.y, v0.z, v0.w, v1.x, v1.y, v1.z, v1.w};
#pragma unroll
                for (int i = 0; i < 2; ++i)
#pragma unroll
                    for (int e = 0; e < 8; ++e) o[i][e] += aa[i][ss] * vv[e];
            }
        }
#pragma unroll
        for (int i = 0; i < 2; ++i) {
            float ss = 0.f;
#pragma unroll
            for (int e = 0; e < 8; ++e) ss += o[i][e] * o[i][e];
            ss += __shfl_xor(ss, 8, 64); ss += __shfl_xor(ss, 4, 64); ss += __shfl_xor(ss, 2, 64); ss += __shfl_xor(ss, 1, 64);
            const float rstd = rsqrtf(ss * (1.0f / 128.0f) + EPS);
            const int t = ty + 32 * i;
#pragma unroll
            for (int j = 0; j < 2; ++j) {
                const int v = 4 * tx + 64 * j;
                const uint2 gq = *(const uint2*)(PROJ + (size_t)(tok0 + t) * INW + 1536 + h * 128 + v);
                const float4 gw = *(const float4*)(gnw + v);
                const float r0 = o[i][4 * j + 0] * rstd * gw.x * siluf_(bflo(gq.x));
                const float r1 = o[i][4 * j + 1] * rstd * gw.y * siluf_(bfhi(gq.x));
                const float r2 = o[i][4 * j + 2] * rstd * gw.z * siluf_(bflo(gq.y));
                const float r3 = o[i][4 * j + 3] * rstd * gw.w * siluf_(bfhi(gq.y));
                *(uint2*)(OCAT + (size_t)(tok0 + t) * 1024 + h * 128 + v) = make_uint2(pack2(r0, r1), pack2(r2, r3));
            }
        }
        __syncthreads();
    }
}

template <bool FINAL>
__device__ void phase_s5_scan(const Params& p, unsigned char* lds) {
    const int tid = threadIdx.x, lane = tid & 63, wave = tid >> 6;
    float* U = (float*)lds + wave * 1024;
    float* Y = (float*)(lds + 32768) + wave * 1024;
    const bf16_t* PROJ = (const bf16_t*)(p.ws + OFF_PROJ);
    const float* AB = (const float*)(p.ws + OFF_S5AB);
    const float* BBR = (const float*)(p.ws + OFF_S5BB); const float* BBI = BBR + 32 * 64 * 16;
    float* END = (float*)(p.ws + OFF_S5END);
    const float* CAR = (const float*)(p.ws + OFF_S5CAR);
    bf16_t* YG = (bf16_t*)(p.ws + OFF_YG);
    const float* cre_g = p.in[15]; const float* cim_g = p.in[16]; const float* dsk = p.in[17];
    for (int item = blockIdx.x; item < 256; item += gridDim.x) {
        const int unit = item * NWAVE + wave;
        const int seg = unit & 31, g = (unit >> 5) & 31, b = unit >> 10;
        float bre[16], bim[16], cre[16], cim[16];
#pragma unroll
        for (int h = 0; h < 16; ++h) { bre[h] = BBR[(g * 64 + lane) * 16 + h]; bim[h] = BBI[(g * 64 + lane) * 16 + h]; }
        if (FINAL) {
#pragma unroll
            for (int h = 0; h < 16; ++h) { cre[h] = cre_g[(g * 16 + h) * 64 + lane]; cim[h] = cim_g[(g * 16 + h) * 64 + lane]; }
        }
        const float are = AB[g * 64 + lane], aim = AB[2048 + g * 64 + lane];
        float xr = 0.f, xi = 0.f;
        const size_t sidx = (((size_t)b * 32 + g) * 32 + seg) * 128 + lane * 2;
        if (FINAL) { xr = CAR[sidx]; xi = CAR[sidx + 1]; }
        for (int tile = 0; tile < S5_SEG / 64; ++tile) {
            const int tokbase = b * SEQ + seg * S5_SEG + tile * 64;
            {
                const uint4* up = (const uint4*)(PROJ + (size_t)(tokbase + lane) * INW + 2048 + g * 16);
                const uint4 ua = up[0], ub = up[1];
                float4* ud = (float4*)(U + lane * 16);
                ud[0] = make_float4(bflo(ua.x), bfhi(ua.x), bflo(ua.y), bfhi(ua.y));
                ud[1] = make_float4(bflo(ua.z), bfhi(ua.z), bflo(ua.w), bfhi(ua.w));
                ud[2] = make_float4(bflo(ub.x), bfhi(ub.x), bflo(ub.y), bfhi(ub.y));
                ud[3] = make_float4(bflo(ub.z), bfhi(ub.z), bflo(ub.w), bfhi(ub.w));
            }
            __syncthreads();
            for (int t = 0; t < 64; ++t) {
                const float4 u0 = *(const float4*)(U + t * 16), u1 = *(const float4*)(U + t * 16 + 4), u2 = *(const float4*)(U + t * 16 + 8), u3 = *(const float4*)(U + t * 16 + 12);
                const float uu[16] = {u0.x, u0.y, u0.z, u0.w, u1.x, u1.y, u1.z, u1.w, u2.x, u2.y, u2.z, u2.w, u3.x, u3.y, u3.z, u3.w};
                float bur = 0.f, bui = 0.f;
#pragma unroll
                for (int h = 0; h < 16; ++h) { bur += uu[h] * bre[h]; bui += uu[h] * bim[h]; }
                const float nxr = are * xr - aim * xi + bur;
                const float nxi = are * xi + aim * xr + bui;
                xr = nxr; xi = nxi;
                if (FINAL) {
                    float yv[16];
#pragma unroll
                    for (int h = 0; h < 16; ++h) yv[h] = xr * cre[h] - xi * cim[h];
                    float r8[8], r4[4], r2[2], r1;
                    const bool b5 = (lane & 32) != 0, b4 = (lane & 16) != 0, b3 = (lane & 8) != 0, b2 = (lane & 4) != 0;
#pragma unroll
                    for (int i = 0; i < 8; ++i) { const float keep = b5 ? yv[i + 8] : yv[i], send = b5 ? yv[i] : yv[i + 8]; r8[i] = keep + __shfl_xor(send, 32, 64); }
#pragma unroll
                    for (int i = 0; i < 4; ++i) { const float keep = b4 ? r8[i + 4] : r8[i], send = b4 ? r8[i] : r8[i + 4]; r4[i] = keep + __shfl_xor(send, 16, 64); }
#pragma unroll
                    for (int i = 0; i < 2; ++i) { const float keep = b3 ? r4[i + 2] : r4[i], send = b3 ? r4[i] : r4[i + 2]; r2[i] = keep + __shfl_xor(send, 8, 64); }
                    { const float keep = b2 ? r2[1] : r2[0], send = b2 ? r2[0] : r2[1]; r1 = keep + __shfl_xor(send, 4, 64); }
                    r1 += __shfl_xor(r1, 2, 64);
                    r1 += __shfl_xor(r1, 1, 64);
                    if ((lane & 3) == 0) Y[t * 16 + (lane >> 2)] = r1;
                }
            }
            __syncthreads();
            if (FINAL) {
                unsigned o[8];
#pragma unroll
                for (int h2 = 0; h2 < 8; ++h2) {
                    const float y0 = Y[lane * 16 + 2 * h2] + dsk[g * 16 + 2 * h2] * U[lane * 16 + 2 * h2];
                    const float y1 = Y[lane * 16 + 2 * h2 + 1] + dsk[g * 16 + 2 * h2 + 1] * U[lane * 16 + 2 * h2 + 1];
                    o[h2] = pack2(geluf_(y0), geluf_(y1));
                }
                uint4* yd = (uint4*)(YG + (size_t)(tokbase + lane) * 512 + g * 16);
                yd[0] = make_uint4(o[0], o[1], o[2], o[3]); yd[1] = make_uint4(o[4], o[5], o[6], o[7]);
                __syncthreads();
            }
        }
        if (!FINAL) { END[sidx] = xr; END[sidx + 1] = xi; }
    }
}
__device__ void phase_s5_carry(const Params& p) {
    const int gtid = blockIdx.x * NT + threadIdx.x, GT = gridDim.x * NT;
    const float* AB = (const float*)(p.ws + OFF_S5AB);
    const float* END = (const float*)(p.ws + OFF_S5END);
    float* CAR = (float*)(p.ws + OFF_S5CAR);
    for (int idx = gtid; idx < 4096; idx += GT) {
        const int pp = idx & 63, g = (idx >> 6) & 31, b = idx >> 11;
        const float ar = AB[4096 + g * 64 + pp], ai = AB[6144 + g * 64 + pp];
        float cr = 0.f, ci = 0.f;
        for (int seg = 0; seg < S5_NSEG; ++seg) {
            const size_t sidx = (((size_t)b * 32 + g) * 32 + seg) * 128 + pp * 2;
            CAR[sidx] = cr; CAR[sidx + 1] = ci;
            const float er = END[sidx], ei = END[sidx + 1];
            const float nr = ar * cr - ai * ci + er, ni = ar * ci + ai * cr + ei;
            cr = nr; ci = ni;
        }
    }
}

constexpr int SCS = 132;
__device__ void phase_topk(const Params& p, unsigned char* lds) {
    const int tid = threadIdx.x, lane = tid & 63, wave = tid >> 6;
    float* sc = (float*)lds + wave * (2 * 16 * SCS);
    const bf16_t* Q = (const bf16_t*)(p.ws + OFF_PROJ);
    const bf16_t* KP = (const bf16_t*)(p.ws + OFF_KEYS);
    int* EIDX = (int*)(p.ws + OFF_EIDX); float* GATE = (float*)(p.ws + OFF_GATE);
    const int h = wave;
    for (int tg = blockIdx.x; tg < NTOK / 16; tg += gridDim.x) {
        const int tok0 = tg * 16;
#pragma unroll
        for (int half = 0; half < 2; ++half) {
            f32x4 acc[8];
#pragma unroll
            for (int n = 0; n < 8; ++n) acc[n] = (f32x4){0.f, 0.f, 0.f, 0.f};
#pragma unroll
            for (int kt = 0; kt < 4; ++kt) {
                const bf16x8 a = *(const bf16x8*)(Q + (size_t)(tok0 + (lane & 15)) * 2048 + h * 256 + half * 128 + kt * 32 + (lane >> 4) * 8);
#pragma unroll
                for (int n = 0; n < 8; ++n) {
                    const bf16x8 bb = *(const bf16x8*)(KP + (size_t)half * 16384 + ((size_t)(n * 4 + kt) * 64 + lane) * 8);
                    acc[n] = __builtin_amdgcn_mfma_f32_16x16x32_bf16(a, bb, acc[n], 0, 0, 0);
                }
            }
#pragma unroll
            for (int n = 0; n < 8; ++n)
#pragma unroll
                for (int r = 0; r < 4; ++r) sc[(half * 16 + 4 * (lane >> 4) + r) * SCS + n * 16 + (lane & 15)] = acc[n][r];
        }
        __syncthreads();
        if (lane < 32) {
            float* row = sc + lane * SCS;
            float tv[16]; int ti[16];
            float pv = INFINITY; int pi = -1;
#pragma unroll
            for (int r = 0; r < 16; ++r) {
                float best = -INFINITY; int bi = 0;
#pragma nounroll
                for (int i4 = 0; i4 < 32; ++i4) {
                    const float4 v4 = *(const float4*)(row + 4 * i4);
                    const float vv[4] = {v4.x, v4.y, v4.z, v4.w};
#pragma unroll
                    for (int e = 0; e < 4; ++e) {
                        const int i = 4 * i4 + e; const float v = vv[e];
                        const bool elig = (v < pv) || (v == pv && i > pi);
                        if (elig && v > best) { best = v; bi = i; }
                    }
                }
                tv[r] = best; ti[r] = bi; pv = best; pi = bi;
            }
#pragma unroll
            for (int r = 0; r < 16; ++r) { row[r] = tv[r]; row[16 + r] = __int_as_float(ti[r]); }
        }
        __syncthreads();
        if (lane < 16) {
            float* r1 = sc + lane * SCS; float* r2 = sc + (16 + lane) * SCS;
            {
                int ci = 32;
#pragma nounroll
                for (int a = 0; a < 16; ++a) {
                    const float va = r1[a]; const int ia = __float_as_int(r1[16 + a]) * 128;
                    const int nbb = 16 / (a + 1);
#pragma nounroll
                    for (int b2 = 0; b2 < nbb; ++b2, ++ci) { r1[ci] = va + r2[b2]; r2[ci] = __int_as_float(ia + __float_as_int(r2[16 + b2])); }
                }
            }
            float sum = 0.f, mx = 0.f;
#pragma nounroll
            for (int r = 0; r < 16; ++r) {
                float best = -INFINITY; int bc = 32;
#pragma nounroll
                for (int ci = 32; ci < 82; ++ci) { const float v = r1[ci]; if (v > best) { best = v; bc = ci; } }
                r1[bc] = -INFINITY;
                if (r == 0) mx = best;
                const float ex = expf(best - mx);
                sum += ex;
                r1[84 + r] = ex; r1[100 + r] = r2[bc];
            }
            const float inv = 1.0f / sum;
            const size_t o = ((size_t)(tok0 + lane) * 8 + h) * 16;
#pragma unroll
            for (int r = 0; r < 16; r += 4) {
                *(int4*)(EIDX + o + r) = make_int4(__float_as_int(r1[100 + r]), __float_as_int(r1[101 + r]), __float_as_int(r1[102 + r]), __float_as_int(r1[103 + r]));
                *(float4*)(GATE + o + r) = make_float4(r1[84 + r] * inv, r1[85 + r] * inv, r1[86 + r] * inv, r1[87 + r] * inv);
            }
        }
        __syncthreads();
    }
}

__device__ void phase_peer(const Params& p) {
    const int tid = threadIdx.x, lane = tid & 63, wave = tid >> 6;
    const int gw = blockIdx.x * NWAVE + wave, GW = gridDim.x * NWAVE;
    const bf16_t* H2 = (const bf16_t*)(p.ws + OFF_H);
    const bf16_t* UT = (const bf16_t*)(p.ws + OFF_UT); const bf16_t* VT = (const bf16_t*)(p.ws + OFF_VT);
    const int* EIDX = (const int*)(p.ws + OFF_EIDX); const float* GATE = (const float*)(p.ws + OFF_GATE);
    const float* mod = (const float*)(p.ws + OFF_MOD);
    const float* fnw = p.in[25];
    float* out = p.out;
    for (int tok = gw; tok < NTOK; tok += GW) {
        const uint4 hA = *(const uint4*)(H2 + (size_t)tok * D + lane * 8), hB = *(const uint4*)(H2 + (size_t)tok * D + 512 + lane * 8);
        const unsigned hq[8] = {hA.x, hA.y, hA.z, hA.w, hB.x, hB.y, hB.z, hB.w};
        float acc[16];
#pragma unroll
        for (int i = 0; i < 16; ++i) acc[i] = 0.f;
        const int e0 = EIDX[(size_t)tok * 128 + lane], e1 = EIDX[(size_t)tok * 128 + 64 + lane];
        const float g0 = GATE[(size_t)tok * 128 + lane], g1 = GATE[(size_t)tok * 128 + 64 + lane];
        for (int j0 = 0; j0 < 128; j0 += 4) {
            uint4 uA[4], uB[4], vA[4], vB[4]; float gt[4];
#pragma unroll
            for (int jj = 0; jj < 4; ++jj) {
                const int j = j0 + jj;
                const int e = __shfl((j < 64) ? e0 : e1, j & 63, 64);
                gt[jj] = __shfl((j < 64) ? g0 : g1, j & 63, 64);
                const bf16_t* ur = UT + (size_t)e * D; const bf16_t* vr = VT + (size_t)e * D;
                uA[jj] = *(const uint4*)(ur + lane * 8); uB[jj] = *(const uint4*)(ur + 512 + lane * 8);
                vA[jj] = *(const uint4*)(vr + lane * 8); vB[jj] = *(const uint4*)(vr + 512 + lane * 8);
            }
#pragma unroll
            for (int jj = 0; jj < 4; ++jj) {
                const unsigned uq[8] = {uA[jj].x, uA[jj].y, uA[jj].z, uA[jj].w, uB[jj].x, uB[jj].y, uB[jj].z, uB[jj].w};
                float d = 0.f;
#pragma unroll
                for (int i = 0; i < 8; ++i) d = __builtin_amdgcn_fdot2_f32_bf16(__builtin_bit_cast(bf2_t, uq[i]), __builtin_bit_cast(bf2_t, hq[i]), d, false);
                d = wave_sum(d);
                const float w = gt[jj] * geluf_(d);
                const unsigned vq[8] = {vA[jj].x, vA[jj].y, vA[jj].z, vA[jj].w, vB[jj].x, vB[jj].y, vB[jj].z, vB[jj].w};
#pragma unroll
                for (int i = 0; i < 8; ++i) { acc[2 * i] += w * bflo(vq[i]); acc[2 * i + 1] += w * bfhi(vq[i]); }
            }
        }
        const int b = tok >> 14;
        float* xrow = out + (size_t)tok * D;
        const float* g2 = mod + b * 6144 + 5120;
        float xo[16]; float ss = 0.f;
#pragma unroll
        for (int q = 0; q < 4; ++q) {
            const int col = (q >> 1) * 512 + lane * 8 + (q & 1) * 4;
            const float4 xv = *(const float4*)(xrow + col), gv = *(const float4*)(g2 + col);
            xo[4 * q + 0] = xv.x + gv.x * acc[4 * q + 0]; xo[4 * q + 1] = xv.y + gv.y * acc[4 * q + 1];
            xo[4 * q + 2] = xv.z + gv.z * acc[4 * q + 2]; xo[4 * q + 3] = xv.w + gv.w * acc[4 * q + 3];
#pragma unroll
            for (int e = 0; e < 4; ++e) ss += xo[4 * q + e] * xo[4 * q + e];
        }
        ss = wave_sum(ss);
        const float rstd = rsqrtf(ss * (1.0f / D) + EPS);
#pragma unroll
        for (int q = 0; q < 4; ++q) {
            const int col = (q >> 1) * 512 + lane * 8 + (q & 1) * 4;
            const float4 wv = *(const float4*)(fnw + col);
            *(float4*)(xrow + col) = make_float4(xo[4 * q] * rstd * wv.x, xo[4 * q + 1] * rstd * wv.y, xo[4 * q + 2] * rstd * wv.z, xo[4 * q + 3] * rstd * wv.w);
        }
    }
}

constexpr int N_PHASES = 12;
template <int PH>
__device__ __forceinline__ void run_phase(const Params& p, unsigned char* lds) {
    unsigned char* ws = p.ws;
    if (PH == 0) phase_prep(p, lds);
    if (PH == 1) phase_norm(p, p.in[0], p.in[4], 0, 1024, (bf16_t*)(ws + OFF_H));
    if (PH == 2) gemm_bf16((const bf16_t*)(ws + OFF_H), D, (const bf16_t*)(ws + OFF_WIN), NTOK, INW, D, EpiStoreBf16{(bf16_t*)(ws + OFF_PROJ), INW});
    if (PH == 3) { phase_hg1(p, lds); phase_s5_scan<false>(p, lds); }
    if (PH == 4) { phase_hg2(p); phase_s5_carry(p); }
    if (PH == 5) { phase_hg3(p, lds); phase_s5_scan<true>(p, lds); }
    if (PH == 6) gemm_bf16((const bf16_t*)(ws + OFF_YG), 512, (const bf16_t*)(ws + OFF_WGLU), NTOK, 512, 512, EpiGlu{(const bf16_t*)(ws + OFF_YG), p.in[19], (bf16_t*)(ws + OFF_OCAT)});
    if (PH == 7) gemm_bf16((const bf16_t*)(ws + OFF_OCAT), D, (const bf16_t*)(ws + OFF_WOUT), NTOK, D, D, EpiOut{p.in[0], (const float*)(ws + OFF_MOD), p.out});
    if (PH == 8) phase_norm(p, p.out, p.in[5], 3072, 4096, (bf16_t*)(ws + OFF_H));
    if (PH == 9) gemm_bf16((const bf16_t*)(ws + OFF_H), D, (const bf16_t*)(ws + OFF_WQ), NTOK, 2048, D, EpiStoreBf16{(bf16_t*)(ws + OFF_PROJ), 2048});
    if (PH == 10) phase_topk(p, lds);
    if (PH == 11) phase_peer(p);
}

template <int PH>
__global__ void __launch_bounds__(NT) k_phase(Params p) {
    __shared__ __attribute__((aligned(16))) unsigned char lds[LDS_BYTES];
    run_phase<PH>(p, lds);
}

#if ONE_LAUNCH
__global__ void __launch_bounds__(NT) k_mega(Params p) {
    __shared__ __attribute__((aligned(16))) unsigned char lds[LDS_BYTES];
    cg::grid_group grid = cg::this_grid();
    run_phase<0>(p, lds); grid.sync();
    run_phase<1>(p, lds); grid.sync();
    run_phase<2>(p, lds); grid.sync();
    run_phase<3>(p, lds); grid.sync();
    run_phase<4>(p, lds); grid.sync();
    run_phase<5>(p, lds); grid.sync();
    run_phase<6>(p, lds); grid.sync();
    run_phase<7>(p, lds); grid.sync();
    run_phase<8>(p, lds); grid.sync();
    run_phase<9>(p, lds); grid.sync();
    run_phase<10>(p, lds); grid.sync();
    run_phase<11>(p, lds);
}

#endif

template <int PH>
static void launch_phase(const Params& p, int grid, hipStream_t stream) {
    hipLaunchKernelGGL(k_phase<PH>, dim3(grid), dim3(NT), 0, stream, p);
}

extern "C" void kernel_launch(void* const* d_in, const int* in_sizes, int n_in, void* d_out, int out_size, void* d_ws, size_t ws_size, hipStream_t stream) {
    if (n_in != 26 || ws_size < WS_END) { fprintf(stderr, "kernel_launch: unexpected inputs (n_in %d, ws %zu)\n", n_in, ws_size); return; }
    Params p{};
    for (int i = 0; i < 26; ++i) p.in[i] = (const float*)d_in[i];
    p.out = (float*)d_out; p.ws = (unsigned char*)d_ws;
#if ONE_LAUNCH
    static int grid = 0;
    if (!grid) {
        int dev = 0, cus = 0, per_cu = 0;
        hipGetDevice(&dev);
        hipDeviceGetAttribute(&cus, hipDeviceAttributeMultiprocessorCount, dev);
        hipOccupancyMaxActiveBlocksPerMultiprocessor(&per_cu, k_mega, NT, 0);
        if (per_cu < 1) per_cu = 1;
        grid = cus;
    }
    void* args[] = {&p};
    hipError_t e = hipLaunchCooperativeKernel((void*)k_mega, dim3(grid), dim3(NT), args, 0, stream);
    if (e != hipSuccess) fprintf(stderr, "cooperative launch failed: %s (grid %d)\n", hipGetErrorString(e), grid);
#else
    const int grid = 256;
    launch_phase<0>(p, grid, stream); launch_phase<1>(p, grid, stream); launch_phase<2>(p, grid, stream);
    launch_phase<3>(p, grid, stream); launch_phase<4>(p, grid, stream); launch_phase<5>(p, grid, stream);
    launch_phase<6>(p, grid, stream); launch_phase<7>(p, grid, stream); launch_phase<8>(p, grid, stream);
    launch_phase<9>(p, grid, stream); launch_phase<10>(p, grid, stream); launch_phase<11>(p, grid, stream);
#endif
}
```

```cpp
#include <hip/hip_runtime.h>
#include <hip/hip_cooperative_groups.h>
#include <stdint.h>
#include <stdio.h>
namespace cg = cooperative_groups;

#ifndef ONE_LAUNCH
#define ONE_LAUNCH 1
#endif

typedef unsigned short bf16_t;
typedef __attribute__((ext_vector_type(8))) short bf16x8;
typedef __attribute__((ext_vector_type(4))) float f32x4;
typedef __attribute__((ext_vector_type(2))) __bf16 bf2_t;

constexpr int D = 1024, BATCH = 2, SEQ = 16384, NTOK = BATCH * SEQ;
constexpr int DK = 128;
constexpr int INW = 2560;
constexpr int NT = 512;
constexpr int NWAVE = NT / 64;
constexpr float EPS = 1e-6f;
constexpr int S5_SEG = 512, S5_NSEG = SEQ / S5_SEG;

constexpr size_t MiB = 1024ull * 1024ull;
constexpr size_t OFF_CTL   = 0;
constexpr size_t OFF_MOD   = 64 * 1024;
constexpr size_t OFF_LB    = OFF_MOD + 48 * 1024;
constexpr size_t OFF_S5AB  = OFF_LB + 2048;
constexpr size_t OFF_S5BB  = OFF_S5AB + 32 * 1024;
constexpr size_t OFF_S5END = 1 * MiB;
constexpr size_t OFF_S5CAR = 2 * MiB;
constexpr size_t OFF_HGDEC = 3 * MiB;
constexpr size_t OFF_WIN   = 4 * MiB;
constexpr size_t OFF_WOUT  = 9 * MiB;
constexpr size_t OFF_WGLU  = 11 * MiB;
constexpr size_t OFF_KEYS  = 11 * MiB + 512 * 1024;
constexpr size_t OFF_WQ    = 12 * MiB;
constexpr size_t OFF_UT    = 16 * MiB;
constexpr size_t OFF_VT    = 48 * MiB;
constexpr size_t OFF_H     = 80 * MiB;
constexpr size_t OFF_PROJ  = 144 * MiB;
constexpr size_t OFF_OCAT  = 304 * MiB;
constexpr size_t OFF_HGS   = 368 * MiB;
constexpr size_t OFF_YG    = 432 * MiB;
constexpr size_t OFF_EIDX  = OFF_HGS;
constexpr size_t OFF_GATE  = OFF_HGS + 16 * MiB;
constexpr size_t WS_END    = 464 * MiB;

constexpr int LDS_BYTES = 139264;

struct Params {
    const float* in[26];
    float* out;
    unsigned char* ws;
};

__device__ __forceinline__ bf16_t f2bf(float f) {
    unsigned u = __float_as_uint(f);
    u += 0x7fffu + ((u >> 16) & 1u);
    return (bf16_t)(u >> 16);
}
__device__ __forceinline__ float bf2f(bf16_t h) { return __uint_as_float(((unsigned)h) << 16); }
__device__ __forceinline__ unsigned pack2(float lo, float hi) { return (unsigned)f2bf(lo) | ((unsigned)f2bf(hi) << 16); }
__device__ __forceinline__ float bflo(unsigned u) { return __uint_as_float(u << 16); }
__device__ __forceinline__ float bfhi(unsigned u) { return __uint_as_float(u & 0xffff0000u); }
__device__ __forceinline__ float sigmoidf_(float x) { return 1.0f / (1.0f + expf(-x)); }
__device__ __forceinline__ float siluf_(float x) { return x / (1.0f + expf(-x)); }
__device__ __forceinline__ float geluf_(float x) { return 0.5f * x * (1.0f + erff(x * 0.70710678118654752f)); }
__device__ __forceinline__ float wave_sum(float v) {
#pragma unroll
    for (int m = 32; m >= 1; m >>= 1) v += __shfl_xor(v, m, 64);
    return v;
}

__device__ void pack_B(const float* __restrict__ W, bf16_t* __restrict__ Wp, int K, int N, int gtid, int GT) {
    const int KT = K / 32;
    const int ngrp = KT * (N / 16) * 64;
    for (int grp = gtid; grp < ngrp; grp += GT) {
        const int l = grp & 63, tile = grp >> 6;
        const int kt = tile % KT, nt = tile / KT;
        const int k0 = kt * 32 + 8 * (l >> 4), n = nt * 16 + (l & 15);
        unsigned o[4];
#pragma unroll
        for (int j = 0; j < 4; ++j) o[j] = pack2(W[(size_t)(k0 + 2 * j) * N + n], W[(size_t)(k0 + 2 * j + 1) * N + n]);
        *(uint4*)(Wp + (size_t)grp * 8) = make_uint4(o[0], o[1], o[2], o[3]);
    }
}
__device__ void pack_BT(const float* __restrict__ Wt, bf16_t* __restrict__ Wp, int K, int N, int gtid, int GT) {
    const int KT = K / 32;
    const int ngrp = KT * (N / 16) * 64;
    for (int grp = gtid; grp < ngrp; grp += GT) {
        const int l = grp & 63, tile = grp >> 6;
        const int kt = tile % KT, nt = tile / KT;
        const int k0 = kt * 32 + 8 * (l >> 4), n = nt * 16 + (l & 15);
        const float* s = Wt + (size_t)n * K + k0;
        unsigned o[4];
#pragma unroll
        for (int j = 0; j < 4; ++j) o[j] = pack2(s[2 * j], s[2 * j + 1]);
        *(uint4*)(Wp + (size_t)grp * 8) = make_uint4(o[0], o[1], o[2], o[3]);
    }
}
__device__ void cvt_table(const float* __restrict__ src, bf16_t* __restrict__ dst, size_t n, int gtid, int GT) {
    const size_t ng = n / 8;
    for (size_t g = gtid; g < ng; g += GT) {
        const float4 a = ((const float4*)src)[2 * g], b = ((const float4*)src)[2 * g + 1];
        *(uint4*)(dst + g * 8) = make_uint4(pack2(a.x, a.y), pack2(a.z, a.w), pack2(b.x, b.y), pack2(b.z, b.w));
    }
}

__device__ void phase_prep(const Params& p, unsigned char* lds) {
    const int tid = threadIdx.x, bid = blockIdx.x, nb = gridDim.x;
    const int lane = tid & 63, wave = tid >> 6;
    const int gtid = bid * NT + tid, GT = nb * NT;
    unsigned char* ws = p.ws;
    {
        const float* c = p.in[1]; const float* aw = p.in[2]; const float* ab = p.in[3];
        float* mod = (float*)(ws + OFF_MOD);
        float* red = (float*)lds;
        for (int item = bid; item < 96; item += nb) {
            const int col = item * 64 + lane;
            float a0 = 0.f, a1 = 0.f;
            for (int k = wave * 128; k < wave * 128 + 128; ++k) {
                const float w = aw[(size_t)k * 6144 + col];
                a0 += siluf_(c[k]) * w; a1 += siluf_(c[1024 + k]) * w;
            }
            red[(wave * 2 + 0) * 64 + lane] = a0; red[(wave * 2 + 1) * 64 + lane] = a1;
            __syncthreads();
            if (tid < 128) {
                const int b = tid >> 6, l = tid & 63;
                float s = 0.f;
                for (int w = 0; w < NWAVE; ++w) s += red[(w * 2 + b) * 64 + l];
                mod[b * 6144 + item * 64 + l] = s + ab[item * 64 + l];
            }
            __syncthreads();
        }
    }
    {
        const float* lbin = p.in[8]; float* lb = (float*)(ws + OFF_LB);
        for (int i = gtid; i < 512; i += GT) {
            const float a = lbin[i], b = lbin[512 + i], m = fmaxf(a, b);
            const float ea = expf(a - m), eb = expf(b - m);
            lb[i] = ea / (ea + eb);
        }
    }
    {
        const float* are = p.in[10]; const float* aim = p.in[11]; const float* ldt = p.in[12];
        const float* bre = p.in[13]; const float* bim = p.in[14];
        float* AB = (float*)(ws + OFF_S5AB); float* BBR = (float*)(ws + OFF_S5BB); float* BBI = BBR + 32 * 64 * 16;
        for (int i = gtid; i < 2048; i += GT) {
            const int g = i >> 6;
            const double ar = are[i], ai = aim[i], dt = exp((double)ldt[g]);
            const double mag = exp(ar * dt), abr = mag * cos(ai * dt), abi = mag * sin(ai * dt);
            const double den = ar * ar + ai * ai, nr = abr - 1.0, ni = abi;
            const double cr = (nr * ar + ni * ai) / den, ci = (ni * ar - nr * ai) / den;
            const double magL = exp(ar * dt * (double)S5_SEG);
            AB[i] = (float)abr; AB[2048 + i] = (float)abi;
            AB[4096 + i] = (float)(magL * cos(ai * dt * (double)S5_SEG)); AB[6144 + i] = (float)(magL * sin(ai * dt * (double)S5_SEG));
            for (int h = 0; h < 16; ++h) {
                const double br = bre[i * 16 + h], bi = bim[i * 16 + h];
                BBR[i * 16 + h] = (float)(cr * br - ci * bi);
                BBI[i * 16 + h] = (float)(cr * bi + ci * br);
            }
        }
    }
    pack_B(p.in[6], (bf16_t*)(ws + OFF_WIN), 1024, 2560, gtid, GT);
    pack_B(p.in[7], (bf16_t*)(ws + OFF_WOUT), 1024, 1024, gtid, GT);
    pack_B(p.in[18], (bf16_t*)(ws + OFF_WGLU), 512, 512, gtid, GT);
    pack_B(p.in[20], (bf16_t*)(ws + OFF_WQ), 1024, 2048, gtid, GT);
    pack_BT(p.in[21], (bf16_t*)(ws + OFF_KEYS), 128, 128, gtid, GT);
    pack_BT(p.in[22], (bf16_t*)(ws + OFF_KEYS) + 128 * 128, 128, 128, gtid, GT);
    cvt_table(p.in[23], (bf16_t*)(ws + OFF_UT), (size_t)16384 * 1024, gtid, GT);
    cvt_table(p.in[24], (bf16_t*)(ws + OFF_VT), (size_t)16384 * 1024, gtid, GT);
}

__device__ void phase_norm(const Params& p, const float* __restrict__ src, const float* __restrict__ nw, int sh_off, int sc_off, bf16_t* __restrict__ dst) {
    const int tid = threadIdx.x, lane = tid & 63, wave = tid >> 6;
    const int gw = blockIdx.x * NWAVE + wave, GW = gridDim.x * NWAVE;
    const float* mod = (const float*)(p.ws + OFF_MOD);
    for (int b = 0; b < BATCH; ++b) {
        float4 fa[4], fs[4];
#pragma unroll
        for (int j = 0; j < 4; ++j) {
            const int c4 = j * 64 + lane;
            const float4 w = ((const float4*)nw)[c4];
            const float4 sc = ((const float4*)(mod + b * 6144 + sc_off))[c4];
            fs[j] = ((const float4*)(mod + b * 6144 + sh_off))[c4];
            fa[j] = make_float4(w.x * (1.f + sc.x), w.y * (1.f + sc.y), w.z * (1.f + sc.z), w.w * (1.f + sc.w));
        }
        for (int r = gw; r < SEQ; r += GW) {
            const size_t row = (size_t)b * SEQ + r;
            const float4* xr = (const float4*)(src + row * D);
            float4 v[4];
            float ss = 0.f;
#pragma unroll
            for (int j = 0; j < 4; ++j) { v[j] = xr[j * 64 + lane]; ss += v[j].x * v[j].x + v[j].y * v[j].y + v[j].z * v[j].z + v[j].w * v[j].w; }
            ss = wave_sum(ss);
            const float rstd = rsqrtf(ss * (1.0f / D) + EPS);
#pragma unroll
            for (int j = 0; j < 4; ++j) {
                const float o0 = v[j].x * rstd * fa[j].x + fs[j].x, o1 = v[j].y * rstd * fa[j].y + fs[j].y;
                const float o2 = v[j].z * rstd * fa[j].z + fs[j].z, o3 = v[j].w * rstd * fa[j].w + fs[j].w;
                *(uint2*)(dst + row * D + (size_t)(j * 64 + lane) * 4) = make_uint2(pack2(o0, o1), pack2(o2, o3));
            }
        }
    }
}

template <class Epi>
__device__ __forceinline__ void gemm_bf16(const bf16_t* __restrict__ A, int lda, const bf16_t* __restrict__ Wp, int M, int N, int K, Epi epi) {
    const int tid = threadIdx.x, lane = tid & 63, wave = tid >> 6;
    const int wm = wave >> 1, wn = wave & 1;
    const int KT = K / 32;
    const int tiles_n = N / 128, tiles = (M / 128) * tiles_n;
    for (int tile = blockIdx.x; tile < tiles; tile += gridDim.x) {
        const int tm = tile / tiles_n, tn = tile % tiles_n;
        const int m0 = tm * 128 + wm * 32, n0 = tn * 128 + wn * 64;
        f32x4 acc[2][4];
#pragma unroll
        for (int i = 0; i < 2; ++i)
#pragma unroll
            for (int j = 0; j < 4; ++j) acc[i][j] = (f32x4){0.f, 0.f, 0.f, 0.f};
        const bf16_t* a0p = A + (size_t)(m0 + (lane & 15)) * lda + (lane >> 4) * 8;
        const bf16_t* a1p = a0p + (size_t)16 * lda;
        const bf16_t* bp = Wp + ((size_t)(n0 / 16) * KT * 64 + lane) * 8;
#pragma unroll 2
        for (int kt = 0; kt < KT; ++kt) {
            const bf16x8 a0 = *(const bf16x8*)(a0p + kt * 32);
            const bf16x8 a1 = *(const bf16x8*)(a1p + kt * 32);
            bf16x8 b[4];
#pragma unroll
            for (int j = 0; j < 4; ++j) b[j] = *(const bf16x8*)(bp + ((size_t)j * KT + kt) * 512);
#pragma unroll
            for (int j = 0; j < 4; ++j) {
                acc[0][j] = __builtin_amdgcn_mfma_f32_16x16x32_bf16(a0, b[j], acc[0][j], 0, 0, 0);
                acc[1][j] = __builtin_amdgcn_mfma_f32_16x16x32_bf16(a1, b[j], acc[1][j], 0, 0, 0);
            }
        }
#pragma unroll
        for (int i = 0; i < 2; ++i)
#pragma unroll
            for (int j = 0; j < 4; ++j)
#pragma unroll
                for (int r = 0; r < 4; ++r) epi(m0 + i * 16 + 4 * (lane >> 4) + r, n0 + j * 16 + (lane & 15), acc[i][j][r]);
    }
}
struct EpiStoreBf16 {
    bf16_t* C; int ldc;
    __device__ __forceinline__ void operator()(int row, int col, float v) const { C[(size_t)row * ldc + col] = f2bf(v); }
};
struct EpiGlu {
    const bf16_t* YG; const float* bias; bf16_t* OC;
    __device__ __forceinline__ void operator()(int row, int col, float v) const {
        const float y = bf2f(YG[(size_t)row * 512 + col]);
        OC[(size_t)row * 1024 + 512 + col] = f2bf(y * sigmoidf_(v + bias[col]));
    }
};
struct EpiOut {
    const float* x; const float* mod; float* out;
    __device__ __forceinline__ void operator()(int row, int col, float v) const {
        const int b = row >> 14;
        out[(size_t)row * D + col] = x[(size_t)row * D + col] + mod[b * 6144 + 2048 + col] * v;
    }
};

constexpr int LS = 136;
__device__ __forceinline__ void hg_prep(const Params& p, float* R0, float* R1, int tok0, int h) {
    const int tid = threadIdx.x;
    const bf16_t* PROJ = (const bf16_t*)(p.ws + OFF_PROJ);
    const float* lb = (const float*)(p.ws + OFF_LB);
    for (int e = tid; e < 64 * 128; e += NT) {
        const int t = e >> 7, k = e & 127;
        const float z = bf2f(PROJ[(size_t)(tok0 + t) * INW + 512 + h * 128 + k]);
        const float lbv = lb[h * 128 + k];
        const float kk = (1.f - lbv) * sigmoidf_(-z);
        R0[t * LS + k] = logf(1.f - kk);
        R1[t * LS + k] = kk;
    }
    __syncthreads();
    if (tid < 128) {
        float s = 0.f;
        for (int t = 0; t < 64; ++t) { s += R0[t * LS + tid]; R0[t * LS + tid] = s; }
    }
    __syncthreads();
}

__device__ void phase_hg1(const Params& p, unsigned char* lds) {
    const int tid = threadIdx.x;
    float* R0 = (float*)lds; float* R1 = R0 + 64 * LS; float* R3 = R0 + 3 * 64 * LS;
    const bf16_t* PROJ = (const bf16_t*)(p.ws + OFF_PROJ);
    bf16_t* HGS = (bf16_t*)(p.ws + OFF_HGS);
    float* DEC = (float*)(p.ws + OFF_HGDEC);
    const int ty = tid >> 4, tx = tid & 15;
    for (int unit = blockIdx.x; unit < 2048; unit += gridDim.x) {
        const int c = unit & 255, h = (unit >> 8) & 3, b = unit >> 10;
        const int tok0 = b * SEQ + c * 64;
        hg_prep(p, R0, R1, tok0, h);
        for (int e = tid; e < 64 * 128; e += NT) {
            const int t = e >> 7, k = e & 127;
            R1[t * LS + k] *= expf(R0[63 * LS + k] - R0[t * LS + k]);
            R3[t * LS + k] = bf2f(PROJ[(size_t)(tok0 + t) * INW + 1024 + h * 128 + k]);
        }
        if (tid < 128) DEC[unit * 128 + tid] = expf(R0[63 * LS + tid]);
        __syncthreads();
        float acc[4][8];
#pragma unroll
        for (int i = 0; i < 4; ++i)
#pragma unroll
            for (int j = 0; j < 8; ++j) acc[i][j] = 0.f;
        for (int s = 0; s < 64; ++s) {
            float kv[4];
#pragma unroll
            for (int i = 0; i < 4; ++i) kv[i] = R1[s * LS + ty + 32 * i];
            const float4 v0 = *(const float4*)&R3[s * LS + 4 * tx], v1 = *(const float4*)&R3[s * LS + 64 + 4 * tx];
#pragma unroll
            for (int i = 0; i < 4; ++i) {
                acc[i][0] += kv[i] * v0.x; acc[i][1] += kv[i] * v0.y; acc[i][2] += kv[i] * v0.z; acc[i][3] += kv[i] * v0.w;
                acc[i][4] += kv[i] * v1.x; acc[i][5] += kv[i] * v1.y; acc[i][6] += kv[i] * v1.z; acc[i][7] += kv[i] * v1.w;
            }
        }
#pragma unroll
        for (int i = 0; i < 4; ++i) {
            bf16_t* d = HGS + ((size_t)unit * 128 + ty + 32 * i) * 128;
            *(uint2*)(d + 4 * tx) = make_uint2(pack2(acc[i][0], acc[i][1]), pack2(acc[i][2], acc[i][3]));
            *(uint2*)(d + 64 + 4 * tx) = make_uint2(pack2(acc[i][4], acc[i][5]), pack2(acc[i][6], acc[i][7]));
        }
        __syncthreads();
    }
}

__device__ void phase_hg2(const Params& p) {
    const int gtid = blockIdx.x * NT + threadIdx.x, GT = gridDim.x * NT;
    const bf16_t* __restrict__ HGS = (const bf16_t*)(p.ws + OFF_HGS);
    bf16_t* __restrict__ SST = (bf16_t*)(p.ws + OFF_H);
    const float* __restrict__ DEC = (const float*)(p.ws + OFF_HGDEC);
    for (int idx = gtid; idx < 8 * 16384; idx += GT) {
        const int bh = idx >> 14, kv = idx & 16383, k = kv >> 7;
        float s = 0.f;
#pragma unroll 8
        for (int c = 0; c < 256; ++c) {
            const size_t unit = (size_t)bh * 256 + c;
            const float loc = bf2f(HGS[unit * 16384 + kv]);
            const float d = DEC[unit * 128 + k];
            SST[unit * 16384 + kv] = f2bf(s);
            s = d * s + loc;
        }
    }
}

__device__ void phase_hg3(const Params& p, unsigned char* lds) {
    const int tid = threadIdx.x;
    float* R0 = (float*)lds; float* R1 = R0 + 64 * LS; float* R2 = R0 + 2 * 64 * LS; float* R3 = R0 + 3 * 64 * LS;
    bf16_t* S1 = (bf16_t*)R1;
    const bf16_t* PROJ = (const bf16_t*)(p.ws + OFF_PROJ);
    const bf16_t* SST = (const bf16_t*)(p.ws + OFF_H);
    bf16_t* OCAT = (bf16_t*)(p.ws + OFF_OCAT);
    const float* gnw = p.in[9];
    const int ty = tid >> 4, tx = tid & 15;
    for (int unit = blockIdx.x; unit < 2048; unit += gridDim.x) {
        const int c = unit & 255, h = (unit >> 8) & 3, b = unit >> 10;
        const int tok0 = b * SEQ + c * 64;
        hg_prep(p, R0, R1, tok0, h);
        for (int e = tid; e < 64 * 128; e += NT) {
            const int t = e >> 7, k = e & 127;
            const float bc = R0[t * LS + k];
            const size_t base = (size_t)(tok0 + t) * INW + h * 128 + k;
            const float q = bf2f(PROJ[base]);
            R2[t * LS + k] = siluf_(q) * 0.08838834764831845f * expf(bc);
            R1[t * LS + k] *= expf(-bc);
            R3[t * LS + k] = bf2f(PROJ[base + 1024]);
        }
        __syncthreads();
        float sc[2][4];
#pragma unroll
        for (int i = 0; i < 2; ++i)
#pragma unroll
            for (int j = 0; j < 4; ++j) sc[i][j] = 0.f;
        for (int k4 = 0; k4 < 32; ++k4) {
            float4 q[2], kk[4];
#pragma unroll
            for (int i = 0; i < 2; ++i) q[i] = *(const float4*)&R2[(ty + 32 * i) * LS + 4 * k4];
#pragma unroll
            for (int j = 0; j < 4; ++j) kk[j] = *(const float4*)&R1[(tx + 16 * j) * LS + 4 * k4];
#pragma unroll
            for (int i = 0; i < 2; ++i)
#pragma unroll
                for (int j = 0; j < 4; ++j) sc[i][j] += q[i].x * kk[j].x + q[i].y * kk[j].y + q[i].z * kk[j].z + q[i].w * kk[j].w;
        }
        __syncthreads();
#pragma unroll
        for (int i = 0; i < 2; ++i)
#pragma unroll
            for (int j = 0; j < 4; ++j) {
                const int t = ty + 32 * i, s = tx + 16 * j;
                R0[t * LS + s] = (s <= t) ? sc[i][j] : 0.f;
            }
        {
            const bf16_t* Sg = SST + (size_t)unit * 16384;
#pragma unroll
            for (int j = 0; j < 8; ++j) {
                const int ci = tid + NT * j, row = ci >> 5, c4 = ci & 31;
                *(uint2*)(S1 + row * LS + c4 * 4) = *(const uint2*)(Sg + row * 128 + c4 * 4);
            }
        }
        __syncthreads();
        float o[2][8];
#pragma unroll
        for (int i = 0; i < 2; ++i)
#pragma unroll
            for (int j = 0; j < 8; ++j) o[i][j] = 0.f;
        for (int k4 = 0; k4 < 32; ++k4) {
            float qa[2][4];
#pragma unroll
            for (int i = 0; i < 2; ++i) { const float4 t4 = *(const float4*)&R2[(ty + 32 * i) * LS + 4 * k4]; qa[i][0] = t4.x; qa[i][1] = t4.y; qa[i][2] = t4.z; qa[i][3] = t4.w; }
#pragma unroll
            for (int kk = 0; kk < 4; ++kk) {
                const uint2 s0 = *(const uint2*)(S1 + (4 * k4 + kk) * LS + 4 * tx), s1 = *(const uint2*)(S1 + (4 * k4 + kk) * LS + 64 + 4 * tx);
                const float sv[8] = {bflo(s0.x), bfhi(s0.x), bflo(s0.y), bfhi(s0.y), bflo(s1.x), bfhi(s1.x), bflo(s1.y), bfhi(s1.y)};
#pragma unroll
                for (int i = 0; i < 2; ++i)
#pragma unroll
                    for (int e = 0; e < 8; ++e) o[i][e] += qa[i][kk] * sv[e];
            }
        }
        for (int s4 = 0; s4 < 16; ++s4) {
            float aa[2][4];
#pragma unroll
            for (int i = 0; i < 2; ++i) { const float4 t4 = *(const float4*)&R0[(ty + 32 * i) * LS + 4 * s4]; aa[i][0] = t4.x; aa[i][1] = t4.y; aa[i][2] = t4.z; aa[i][3] = t4.w; }
#pragma unroll
            for (int ss = 0; ss < 4; ++ss) {
                const float4 v0 = *(const float4*)&R3[(4 * s4 + ss) * LS + 4 * tx], v1 = *(const float4*)&R3[(4 * s4 + ss) * LS + 64 + 4 * tx];
                const float vv[8] = {v0.x, v0.y, v0.z, v0.w, v1.x, v1.y, v1.z, v1.w};
#pragma unroll
                for (int i = 0; i < 2; ++i)
#pragma unroll
                    for (int e = 0; e < 8; ++e) o[i][e] += aa[i][ss] * vv[e];
            }
        }
#pragma unroll
        for (int i = 0; i < 2; ++i) {
            float ss = 0.f;
#pragma unroll
            for (int e = 0; e < 8; ++e) ss += o[i][e] * o[i][e];
            ss += __shfl_xor(ss, 8, 64); ss += __shfl_xor(ss, 4, 64); ss += __shfl_xor(ss, 2, 64); ss += __shfl_xor(ss, 1, 64);
            const float rstd = rsqrtf(ss * (1.0f / 128.0f) + EPS);
            const int t = ty + 32 * i;
#pragma unroll
            for (int j = 0; j < 2; ++j) {
                const int v = 4 * tx + 64 * j;
                const uint2 gq = *(const uint2*)(PROJ + (size_t)(tok0 + t) * INW + 1536 + h * 128 + v);
                const float4 gw = *(const float4*)(gnw + v);
                const float r0 = o[i][4 * j + 0] * rstd * gw.x * siluf_(bflo(gq.x));
                const float r1 = o[i][4 * j + 1] * rstd * gw.y * siluf_(bfhi(gq.x));
                const float r2 = o[i][4 * j + 2] * rstd * gw.z * siluf_(bflo(gq.y));
                const float r3 = o[i][4 * j + 3] * rstd * gw.w * siluf_(bfhi(gq.y));
                *(uint2*)(OCAT + (size_t)(tok0 + t) * 1024 + h * 128 + v) = make_uint2(pack2(r0, r1), pack2(r2, r3));
            }
        }
        __syncthreads();
    }
}

template <bool FINAL>
__device__ void phase_s5_scan(const Params& p, unsigned char* lds) {
    const int tid = threadIdx.x, lane = tid & 63, wave = tid >> 6;
    float* U = (float*)lds + wave * 1024;
    float* Y = (float*)(lds + 32768) + wave * 1024;
    const bf16_t* PROJ = (const bf16_t*)(p.ws + OFF_PROJ);
    const float* AB = (const float*)(p.ws + OFF_S5AB);
    const float* BBR = (const float*)(p.ws + OFF_S5BB); const float* BBI = BBR + 32 * 64 * 16;
    float* END = (float*)(p.ws + OFF_S5END);
    const float* CAR = (const float*)(p.ws + OFF_S5CAR);
    bf16_t* YG = (bf16_t*)(p.ws + OFF_YG);
    const float* cre_g = p.in[15]; const float* cim_g = p.in[16]; const float* dsk = p.in[17];
    for (int item = blockIdx.x; item < 256; item += gridDim.x) {
        const int unit = item * NWAVE + wave;
        const int seg = unit & 31, g = (unit >> 5) & 31, b = unit >> 10;
        float bre[16], bim[16], cre[16], cim[16];
#pragma unroll
        for (int h = 0; h < 16; ++h) { bre[h] = BBR[(g * 64 + lane) * 16 + h]; bim[h] = BBI[(g * 64 + lane) * 16 + h]; }
        if (FINAL) {
#pragma unroll
            for (int h = 0; h < 16; ++h) { cre[h] = cre_g[(g * 16 + h) * 64 + lane]; cim[h] = cim_g[(g * 16 + h) * 64 + lane]; }
        }
        const float are = AB[g * 64 + lane], aim = AB[2048 + g * 64 + lane];
        float xr = 0.f, xi = 0.f;
        const size_t sidx = (((size_t)b * 32 + g) * 32 + seg) * 128 + lane * 2;
        if (FINAL) { xr = CAR[sidx]; xi = CAR[sidx + 1]; }
        for (int tile = 0; tile < S5_SEG / 64; ++tile) {
            const int tokbase = b * SEQ + seg * S5_SEG + tile * 64;
            {
                const uint4* up = (const uint4*)(PROJ + (size_t)(tokbase + lane) * INW + 2048 + g * 16);
                const uint4 ua = up[0], ub = up[1];
                float4* ud = (float4*)(U + lane * 16);
                ud[0] = make_float4(bflo(ua.x), bfhi(ua.x), bflo(ua.y), bfhi(ua.y));
                ud[1] = make_float4(bflo(ua.z), bfhi(ua.z), bflo(ua.w), bfhi(ua.w));
                ud[2] = make_float4(bflo(ub.x), bfhi(ub.x), bflo(ub.y), bfhi(ub.y));
                ud[3] = make_float4(bflo(ub.z), bfhi(ub.z), bflo(ub.w), bfhi(ub.w));
            }
            __syncthreads();
            for (int t = 0; t < 64; ++t) {
                const float4 u0 = *(const float4*)(U + t * 16), u1 = *(const float4*)(U + t * 16 + 4), u2 = *(const float4*)(U + t * 16 + 8), u3 = *(const float4*)(U + t * 16 + 12);
                const float uu[16] = {u0.x, u0.y, u0.z, u0.w, u1.x, u1.y, u1.z, u1.w, u2.x, u2.y, u2.z, u2.w, u3.x, u3.y, u3.z, u3.w};
                float bur = 0.f, bui = 0.f;
#pragma unroll
                for (int h = 0; h < 16; ++h) { bur += uu[h] * bre[h]; bui += uu[h] * bim[h]; }
                const float nxr = are * xr - aim * xi + bur;
                const float nxi = are * xi + aim * xr + bui;
                xr = nxr; xi = nxi;
                if (FINAL) {
                    float yv[16];
#pragma unroll
                    for (int h = 0; h < 16; ++h) yv[h] = xr * cre[h] - xi * cim[h];
                    float r8[8], r4[4], r2[2], r1;
                    const bool b5 = (lane & 32) != 0, b4 = (lane & 16) != 0, b3 = (lane & 8) != 0, b2 = (lane & 4) != 0;
#pragma unroll
                    for (int i = 0; i < 8; ++i) { const float keep = b5 ? yv[i + 8] : yv[i], send = b5 ? yv[i] : yv[i + 8]; r8[i] = keep + __shfl_xor(send, 32, 64); }
#pragma unroll
                    for (int i = 0; i < 4; ++i) { const float keep = b4 ? r8[i + 4] : r8[i], send = b4 ? r8[i] : r8[i + 4]; r4[i] = keep + __shfl_xor(send, 16, 64); }
#pragma unroll
                    for (int i = 0; i < 2; ++i) { const float keep = b3 ? r4[i + 2] : r4[i], send = b3 ? r4[i] : r4[i + 2]; r2[i] = keep + __shfl_xor(send, 8, 64); }
                    { const float keep = b2 ? r2[1] : r2[0], send = b2 ? r2[0] : r2[1]; r1 = keep + __shfl_xor(send, 4, 64); }
                    r1 += __shfl_xor(r1, 2, 64);
                    r1 += __shfl_xor(r1, 1, 64);
                    if ((lane & 3) == 0) Y[t * 16 + (lane >> 2)] = r1;
                }
            }
            __syncthreads();
            if (FINAL) {
                unsigned o[8];
#pragma unroll
                for (int h2 = 0; h2 < 8; ++h2) {
                    const float y0 = Y[lane * 16 + 2 * h2] + dsk[g * 16 + 2 * h2] * U[lane * 16 + 2 * h2];
                    const float y1 = Y[lane * 16 + 2 * h2 + 1] + dsk[g * 16 + 2 * h2 + 1] * U[lane * 16 + 2 * h2 + 1];
                    o[h2] = pack2(geluf_(y0), geluf_(y1));
                }
                uint4* yd = (uint4*)(YG + (size_t)(tokbase + lane) * 512 + g * 16);
                yd[0] = make_uint4(o[0], o[1], o[2], o[3]); yd[1] = make_uint4(o[4], o[5], o[6], o[7]);
                __syncthreads();
            }
        }
        if (!FINAL) { END[sidx] = xr; END[sidx + 1] = xi; }
    }
}
__device__ void phase_s5_carry(const Params& p) {
    const int gtid = blockIdx.x * NT + threadIdx.x, GT = gridDim.x * NT;
    const float* AB = (const float*)(p.ws + OFF_S5AB);
    const float* END = (const float*)(p.ws + OFF_S5END);
    float* CAR = (float*)(p.ws + OFF_S5CAR);
    for (int idx = gtid; idx < 4096; idx += GT) {
        const int pp = idx & 63, g = (idx >> 6) & 31, b = idx >> 11;
        const float ar = AB[4096 + g * 64 + pp], ai = AB[6144 + g * 64 + pp];
        float cr = 0.f, ci = 0.f;
        for (int seg = 0; seg < S5_NSEG; ++seg) {
            const size_t sidx = (((size_t)b * 32 + g) * 32 + seg) * 128 + pp * 2;
            CAR[sidx] = cr; CAR[sidx + 1] = ci;
            const float er = END[sidx], ei = END[sidx + 1];
            const float nr = ar * cr - ai * ci + er, ni = ar * ci + ai * cr + ei;
            cr = nr; ci = ni;
        }
    }
}

template <int N>
__device__ __forceinline__ void bitonic_sort_desc(float (&v)[N]) {
#pragma unroll
    for (int k = 2; k <= N; k <<= 1)
#pragma unroll
        for (int j = k >> 1; j > 0; j >>= 1)
#pragma unroll
            for (int i = 0; i < N; ++i) {
                const int l = i ^ j;
                if (l > i) {
                    const bool desc = ((i & k) == 0) || (k == N);
                    const float hi = fmaxf(v[i], v[l]), lo = fminf(v[i], v[l]);
                    v[i] = desc ? hi : lo; v[l] = desc ? lo : hi;
                }
            }
}
__device__ __forceinline__ void merge16_desc(float (&x)[16], const float (&y)[16]) {
#pragma unroll
    for (int i = 0; i < 16; ++i) x[i] = fmaxf(x[i], y[15 - i]);
#pragma unroll
    for (int j = 8; j > 0; j >>= 1)
#pragma unroll
        for (int i = 0; i < 16; ++i) {
            const int l = i ^ j;
            if (l > i) { const float hi = fmaxf(x[i], x[l]), lo = fminf(x[i], x[l]); x[i] = hi; x[l] = lo; }
        }
}
__device__ __forceinline__ void xlane_merge16(float (&x)[16]) {
    float y[16];
#pragma unroll
    for (int i = 0; i < 16; ++i) y[i] = __shfl_xor(x[i], 16, 64);
    merge16_desc(x, y);
#pragma unroll
    for (int i = 0; i < 16; ++i) y[i] = __shfl_xor(x[i], 32, 64);
    merge16_desc(x, y);
}
__device__ __forceinline__ float pk(float v, unsigned payload, unsigned mask) { return __uint_as_float((__float_as_uint(v) & ~mask) | payload); }

__device__ void phase_topk(const Params& p, unsigned char* lds) {
    const int tid = threadIdx.x, lane = tid & 63, wave = tid >> 6;
    const int c = lane & 15, q = lane >> 4;
    int* KT = (int*)lds + wave * (16 * 32);
    const bf16_t* Q = (const bf16_t*)(p.ws + OFF_PROJ);
    const bf16_t* KP = (const bf16_t*)(p.ws + OFF_KEYS);
    int* EIDX = (int*)(p.ws + OFF_EIDX); float* GATE = (float*)(p.ws + OFF_GATE);
    const int h = wave;
    constexpr int CA[48] = {1, 1, 1, 1, 1, 1, 1, 1, 2, 2, 2, 2, 2, 3, 3, 3, 3, 4, 4, 4, 5, 5, 6, 6, 7, 7, 8, 9, 10, 11, 12, 13, 14, 15, -1, -1, -1, -1, -1, -1, -1, -1, -1, -1, -1, -1, -1, -1};
    constexpr int CB[48] = {0, 1, 2, 3, 4, 5, 6, 7, 0, 1, 2, 3, 4, 0, 1, 2, 3, 0, 1, 2, 0, 1, 0, 1, 0, 1, 0, 0, 0, 0, 0, 0, 0, 0, -1, -1, -1, -1, -1, -1, -1, -1, -1, -1, -1, -1, -1, -1};
    for (int tg = blockIdx.x; tg < NTOK / 16; tg += gridDim.x) {
        const int tok0 = tg * 16;
        float top[2][16];
#pragma unroll
        for (int half = 0; half < 2; ++half) {
            f32x4 acc[8];
#pragma unroll
            for (int m = 0; m < 8; ++m) acc[m] = (f32x4){0.f, 0.f, 0.f, 0.f};
#pragma unroll
            for (int kt = 0; kt < 4; ++kt) {
                const bf16x8 bq = *(const bf16x8*)(Q + (size_t)(tok0 + c) * 2048 + h * 256 + half * 128 + kt * 32 + q * 8);
#pragma unroll
                for (int m = 0; m < 8; ++m) {
                    const bf16x8 ak = *(const bf16x8*)(KP + (size_t)half * 16384 + ((size_t)(m * 4 + kt) * 64 + lane) * 8);
                    acc[m] = __builtin_amdgcn_mfma_f32_16x16x32_bf16(ak, bq, acc[m], 0, 0, 0);
                }
            }
            float lo16[16], hi16[16];
#pragma unroll
            for (int m = 0; m < 4; ++m)
#pragma unroll
                for (int r = 0; r < 4; ++r) {
                    lo16[m * 4 + r] = pk(acc[m][r], (unsigned)(m * 16 + 4 * q + r), 127u);
                    hi16[m * 4 + r] = pk(acc[m + 4][r], (unsigned)((m + 4) * 16 + 4 * q + r), 127u);
                }
            bitonic_sort_desc<16>(lo16);
            bitonic_sort_desc<16>(hi16);
            merge16_desc(lo16, hi16);
            xlane_merge16(lo16);
#pragma unroll
            for (int i = 0; i < 16; ++i) top[half][i] = lo16[i];
        }
        if (q == 0) {
#pragma unroll
            for (int i = 0; i < 16; i += 4) {
                *(int4*)(KT + c * 32 + i) = make_int4(__float_as_int(top[0][i]) & 127, __float_as_int(top[0][i + 1]) & 127, __float_as_int(top[0][i + 2]) & 127, __float_as_int(top[0][i + 3]) & 127);
                *(int4*)(KT + c * 32 + 16 + i) = make_int4(__float_as_int(top[1][i]) & 127, __float_as_int(top[1][i + 1]) & 127, __float_as_int(top[1][i + 2]) & 127, __float_as_int(top[1][i + 3]) & 127);
            }
        }
        float g0[16], g1[16], g2[16], g3[16];
#pragma unroll
        for (int b2 = 0; b2 < 16; ++b2) g0[b2] = pk(top[0][0] + top[1][b2], (unsigned)b2, 255u);
#pragma unroll
        for (int n = 0; n < 16; ++n) {
            g1[n] = (CA[n] >= 0) ? pk(top[0][CA[n] < 0 ? 0 : CA[n]] + top[1][CB[n] < 0 ? 0 : CB[n]], (unsigned)(CA[n] * 16 + CB[n]), 255u) : -INFINITY;
            g2[n] = (CA[16 + n] >= 0) ? pk(top[0][CA[16 + n] < 0 ? 0 : CA[16 + n]] + top[1][CB[16 + n] < 0 ? 0 : CB[16 + n]], (unsigned)(CA[16 + n] * 16 + CB[16 + n]), 255u) : -INFINITY;
            g3[n] = (CA[32 + n] >= 0) ? pk(top[0][CA[32 + n] < 0 ? 0 : CA[32 + n]] + top[1][CB[32 + n] < 0 ? 0 : CB[32 + n]], (unsigned)(CA[32 + n] * 16 + CB[32 + n]), 255u) : -INFINITY;
        }
        bitonic_sort_desc<16>(g0); bitonic_sort_desc<16>(g1); bitonic_sort_desc<16>(g2); bitonic_sort_desc<16>(g3);
        merge16_desc(g0, g1); merge16_desc(g2, g3); merge16_desc(g0, g2);
        float sum = 0.f, ex[16];
        const float mx = __uint_as_float(__float_as_uint(g0[0]) & ~255u);
#pragma unroll
        for (int r = 0; r < 16; ++r) { ex[r] = expf(__uint_as_float(__float_as_uint(g0[r]) & ~255u) - mx); sum += ex[r]; }
        const float inv = 1.0f / sum;
        __syncthreads();
        int eo[4]; float go[4];
#pragma unroll
        for (int i = 0; i < 4; ++i) {
            const float xv = (q == 0) ? g0[i] : (q == 1) ? g0[4 + i] : (q == 2) ? g0[8 + i] : g0[12 + i];
            const float xe = (q == 0) ? ex[i] : (q == 1) ? ex[4 + i] : (q == 2) ? ex[8 + i] : ex[12 + i];
            const unsigned pl = __float_as_uint(xv) & 255u;
            eo[i] = KT[c * 32 + (pl >> 4)] * 128 + KT[c * 32 + 16 + (pl & 15u)];
            go[i] = xe * inv;
        }
        const size_t o = ((size_t)(tok0 + c) * 8 + h) * 16 + 4 * q;
        *(int4*)(EIDX + o) = make_int4(eo[0], eo[1], eo[2], eo[3]);
        *(float4*)(GATE + o) = make_float4(go[0], go[1], go[2], go[3]);
        __syncthreads();
    }
}

__device__ void phase_peer(const Params& p) {
    const int tid = threadIdx.x, lane = tid & 63, wave = tid >> 6;
    const int gw = blockIdx.x * NWAVE + wave, GW = gridDim.x * NWAVE;
    const bf16_t* H2 = (const bf16_t*)(p.ws + OFF_H);
    const bf16_t* UT = (const bf16_t*)(p.ws + OFF_UT); const bf16_t* VT = (const bf16_t*)(p.ws + OFF_VT);
    const int* EIDX = (const int*)(p.ws + OFF_EIDX); const float* GATE = (const float*)(p.ws + OFF_GATE);
    const float* mod = (const float*)(p.ws + OFF_MOD);
    const float* fnw = p.in[25];
    float* out = p.out;
    for (int tok = gw; tok < NTOK; tok += GW) {
        const uint4 hA = *(const uint4*)(H2 + (size_t)tok * D + lane * 8), hB = *(const uint4*)(H2 + (size_t)tok * D + 512 + lane * 8);
        const unsigned hq[8] = {hA.x, hA.y, hA.z, hA.w, hB.x, hB.y, hB.z, hB.w};
        float acc[16];
#pragma unroll
        for (int i = 0; i < 16; ++i) acc[i] = 0.f;
        const int e0 = EIDX[(size_t)tok * 128 + lane], e1 = EIDX[(size_t)tok * 128 + 64 + lane];
        const float g0 = GATE[(size_t)tok * 128 + lane], g1 = GATE[(size_t)tok * 128 + 64 + lane];
        for (int j0 = 0; j0 < 128; j0 += 4) {
            uint4 uA[4], uB[4], vA[4], vB[4]; float gt[4];
#pragma unroll
            for (int jj = 0; jj < 4; ++jj) {
                const int j = j0 + jj;
                const int e = __shfl((j < 64) ? e0 : e1, j & 63, 64);
                gt[jj] = __shfl((j < 64) ? g0 : g1, j & 63, 64);
                const bf16_t* ur = UT + (size_t)e * D; const bf16_t* vr = VT + (size_t)e * D;
                uA[jj] = *(const uint4*)(ur + lane * 8); uB[jj] = *(const uint4*)(ur + 512 + lane * 8);
                vA[jj] = *(const uint4*)(vr + lane * 8); vB[jj] = *(const uint4*)(vr + 512 + lane * 8);
            }
#pragma unroll
            for (int jj = 0; jj < 4; ++jj) {
                const unsigned uq[8] = {uA[jj].x, uA[jj].y, uA[jj].z, uA[jj].w, uB[jj].x, uB[jj].y, uB[jj].z, uB[jj].w};
                float d = 0.f;
#pragma unroll
                for (int i = 0; i < 8; ++i) d = __builtin_amdgcn_fdot2_f32_bf16(__builtin_bit_cast(bf2_t, uq[i]), __builtin_bit_cast(bf2_t, hq[i]), d, false);
                d = wave_sum(d);
                const float w = gt[jj] * geluf_(d);
                const unsigned vq[8] = {vA[jj].x, vA[jj].y, vA[jj].z, vA[jj].w, vB[jj].x, vB[jj].y, vB[jj].z, vB[jj].w};
#pragma unroll
                for (int i = 0; i < 8; ++i) { acc[2 * i] += w * bflo(vq[i]); acc[2 * i + 1] += w * bfhi(vq[i]); }
            }
        }
        const int b = tok >> 14;
        float* xrow = out + (size_t)tok * D;
        const float* g2 = mod + b * 6144 + 5120;
        float xo[16]; float ss = 0.f;
#pragma unroll
        for (int q = 0; q < 4; ++q) {
            const int col = (q >> 1) * 512 + lane * 8 + (q & 1) * 4;
            const float4 xv = *(const float4*)(xrow + col), gv = *(const float4*)(g2 + col);
            xo[4 * q + 0] = xv.x + gv.x * acc[4 * q + 0]; xo[4 * q + 1] = xv.y + gv.y * acc[4 * q + 1];
            xo[4 * q + 2] = xv.z + gv.z * acc[4 * q + 2]; xo[4 * q + 3] = xv.w + gv.w * acc[4 * q + 3];
#pragma unroll
            for (int e = 0; e < 4; ++e) ss += xo[4 * q + e] * xo[4 * q + e];
        }
        ss = wave_sum(ss);
        const float rstd = rsqrtf(ss * (1.0f / D) + EPS);
#pragma unroll
        for (int q = 0; q < 4; ++q) {
            const int col = (q >> 1) * 512 + lane * 8 + (q & 1) * 4;
            const float4 wv = *(const float4*)(fnw + col);
            *(float4*)(xrow + col) = make_float4(xo[4 * q] * rstd * wv.x, xo[4 * q + 1] * rstd * wv.y, xo[4 * q + 2] * rstd * wv.z, xo[4 * q + 3] * rstd * wv.w);
        }
    }
}

constexpr int N_PHASES = 12;
template <int PH>
__device__ __forceinline__ void run_phase(const Params& p, unsigned char* lds) {
    unsigned char* ws = p.ws;
    if (PH == 0) phase_prep(p, lds);
    if (PH == 1) phase_norm(p, p.in[0], p.in[4], 0, 1024, (bf16_t*)(ws + OFF_H));
    if (PH == 2) gemm_bf16((const bf16_t*)(ws + OFF_H), D, (const bf16_t*)(ws + OFF_WIN), NTOK, INW, D, EpiStoreBf16{(bf16_t*)(ws + OFF_PROJ), INW});
    if (PH == 3) { phase_hg1(p, lds); phase_s5_scan<false>(p, lds); }
    if (PH == 4) { phase_hg2(p); phase_s5_carry(p); }
    if (PH == 5) { phase_hg3(p, lds); phase_s5_scan<true>(p, lds); }
    if (PH == 6) gemm_bf16((const bf16_t*)(ws + OFF_YG), 512, (const bf16_t*)(ws + OFF_WGLU), NTOK, 512, 512, EpiGlu{(const bf16_t*)(ws + OFF_YG), p.in[19], (bf16_t*)(ws + OFF_OCAT)});
    if (PH == 7) gemm_bf16((const bf16_t*)(ws + OFF_OCAT), D, (const bf16_t*)(ws + OFF_WOUT), NTOK, D, D, EpiOut{p.in[0], (const float*)(ws + OFF_MOD), p.out});
    if (PH == 8) phase_norm(p, p.out, p.in[5], 3072, 4096, (bf16_t*)(ws + OFF_H));
    if (PH == 9) gemm_bf16((const bf16_t*)(ws + OFF_H), D, (const bf16_t*)(ws + OFF_WQ), NTOK, 2048, D, EpiStoreBf16{(bf16_t*)(ws + OFF_PROJ), 2048});
    if (PH == 10) phase_topk(p, lds);
    if (PH == 11) phase_peer(p);
}

template <int PH>
__global__ void __launch_bounds__(NT) k_phase(Params p) {
    __shared__ __attribute__((aligned(16))) unsigned char lds[LDS_BYTES];
    run_phase<PH>(p, lds);
}

#if ONE_LAUNCH
#ifndef REP_MASK
#define REP_MASK 0
#endif
template <int PH>
__device__ __forceinline__ void run_rep(const Params& p, unsigned char* lds, cg::grid_group& grid) {
    run_phase<PH>(p, lds);
    if (PH != N_PHASES - 1) grid.sync();
    if ((REP_MASK >> PH) & 1) { run_phase<PH>(p, lds); grid.sync(); }
}
__global__ void __launch_bounds__(NT) k_mega(Params p) {
    __shared__ __attribute__((aligned(16))) unsigned char lds[LDS_BYTES];
    cg::grid_group grid = cg::this_grid();
    run_rep<0>(p, lds, grid); run_rep<1>(p, lds, grid); run_rep<2>(p, lds, grid); run_rep<3>(p, lds, grid);
    run_rep<4>(p, lds, grid); run_rep<5>(p, lds, grid); run_rep<6>(p, lds, grid); run_rep<7>(p, lds, grid);
    run_rep<8>(p, lds, grid); run_rep<9>(p, lds, grid); run_rep<10>(p, lds, grid); run_rep<11>(p, lds, grid);
}
#endif

template <int PH>
static void launch_phase(const Params& p, int grid, hipStream_t stream) {
    hipLaunchKernelGGL(k_phase<PH>, dim3(grid), dim3(NT), 0, stream, p);
}

extern "C" void kernel_launch(void* const* d_in, const int* in_sizes, int n_in, void* d_out, int out_size, void* d_ws, size_t ws_size, hipStream_t stream) {
    if (n_in != 26 || ws_size < WS_END) { fprintf(stderr, "kernel_launch: unexpected inputs (n_in %d, ws %zu)\n", n_in, ws_size); return; }
    Params p{};
    for (int i = 0; i < 26; ++i) p.in[i] = (const float*)d_in[i];
    p.out = (float*)d_out; p.ws = (unsigned char*)d_ws;
#if ONE_LAUNCH
    static int grid = 0;
    if (!grid) {
        int dev = 0, cus = 0, per_cu = 0;
        hipGetDevice(&dev);
        hipDeviceGetAttribute(&cus, hipDeviceAttributeMultiprocessorCount, dev);
        hipOccupancyMaxActiveBlocksPerMultiprocessor(&per_cu, k_mega, NT, 0);
        if (per_cu < 1) per_cu = 1;
        grid = cus;
    }
    void* args[] = {&p};
    hipError_t e = hipLaunchCooperativeKernel((void*)k_mega, dim3(grid), dim3(NT), args, 0, stream);
    if (e != hipSuccess) fprintf(stderr, "cooperative launch failed: %s (grid %d)\n", hipGetErrorString(e), grid);
#else
    const int grid = 256;
    launch_phase<0>(p, grid, stream); launch_phase<1>(p, grid, stream); launch_phase<2>(p, grid, stream);
    launch_phase<3>(p, grid, stream); launch_phase<4>(p, grid, stream); launch_phase<5>(p, grid, stream);
    launch_phase<6>(p, grid, stream); launch_phase<7>(p, grid, stream); launch_phase<8>(p, grid, stream);
    launch_phase<9>(p, grid, stream); launch_phase<10>(p, grid, stream); launch_phase<11>(p, grid, stream);
#endif
}
```

```cpp
#include <hip/hip_runtime.h>
#include <hip/hip_cooperative_groups.h>
#include <stdint.h>
#include <stdio.h>
namespace cg = cooperative_groups;

#ifndef ONE_LAUNCH
#define ONE_LAUNCH 1
#endif

#define LAS __attribute__((address_space(3)))
typedef unsigned short bf16_t;
typedef __attribute__((ext_vector_type(8))) short bf16x8;
typedef __attribute__((ext_vector_type(4))) float f32x4;
typedef __attribute__((ext_vector_type(2))) __bf16 bf2_t;
typedef unsigned u32x4_t __attribute__((ext_vector_type(4)));
typedef unsigned u32x2_t __attribute__((ext_vector_type(2)));

constexpr int D = 1024, BATCH = 2, SEQ = 16384, NTOK = BATCH * SEQ;
constexpr int DK = 128;
constexpr int INW = 2560;
constexpr int NT = 512;
constexpr int NWAVE = NT / 64;
constexpr float EPS = 1e-6f;
constexpr int S5_SEG = 512, S5_NSEG = SEQ / S5_SEG;

constexpr size_t MiB = 1024ull * 1024ull;
constexpr size_t OFF_CTL   = 0;
constexpr size_t OFF_MOD   = 64 * 1024;
constexpr size_t OFF_LB    = OFF_MOD + 48 * 1024;
constexpr size_t OFF_S5AB  = OFF_LB + 2048;
constexpr size_t OFF_S5BB  = OFF_S5AB + 32 * 1024;
constexpr size_t OFF_MODP  = 512 * 1024;
constexpr size_t OFF_S5END = 1 * MiB;
constexpr size_t OFF_S5CAR = 2 * MiB;
constexpr size_t OFF_HGDEC = 3 * MiB;
constexpr size_t OFF_WIN   = 4 * MiB;
constexpr size_t OFF_WOUT  = 9 * MiB;
constexpr size_t OFF_WGLU  = 11 * MiB;
constexpr size_t OFF_KEYS  = 11 * MiB + 512 * 1024;
constexpr size_t OFF_WQ    = 12 * MiB;
constexpr size_t OFF_UT8   = 16 * MiB;
constexpr size_t OFF_VT8   = 32 * MiB;
constexpr size_t OFF_ISU   = 48 * MiB;
constexpr size_t OFF_ISV   = 48 * MiB + 65536;
constexpr size_t OFF_H     = 80 * MiB;
constexpr size_t OFF_PROJ  = 144 * MiB;
constexpr size_t OFF_OCAT  = 304 * MiB;
constexpr size_t OFF_HGS   = 368 * MiB;
constexpr size_t OFF_YG    = 432 * MiB;
constexpr size_t OFF_EIDX  = OFF_HGS;
constexpr size_t OFF_GATE  = OFF_HGS + 16 * MiB;
constexpr size_t OFF_WG    = OFF_GATE;
constexpr size_t OFF_MIX   = OFF_HGS + 32 * MiB;
constexpr size_t WS_END    = 464 * MiB;

constexpr int LDS_PHASE_BYTES = 139264;
constexpr int LDS_BYTES = LDS_PHASE_BYTES + 16;

struct Params {
    const float* in[26];
    float* out;
    unsigned char* ws;
};

__device__ __forceinline__ bf16_t f2bf(float f) { return __builtin_bit_cast(unsigned short, (__bf16)f); }
__device__ __forceinline__ float bf2f(bf16_t h) { return __uint_as_float(((unsigned)h) << 16); }
__device__ __forceinline__ unsigned pack2(float lo, float hi) { const bf2_t r = {(__bf16)lo, (__bf16)hi}; return __builtin_bit_cast(unsigned, r); }
__device__ __forceinline__ float bflo(unsigned u) { return __uint_as_float(u << 16); }
__device__ __forceinline__ float bfhi(unsigned u) { return __uint_as_float(u & 0xffff0000u); }
__device__ __forceinline__ float fexp(float x) { return __builtin_amdgcn_exp2f(x * 1.44269504088896341f); }
__device__ __forceinline__ float flog(float x) { return __builtin_amdgcn_logf(x) * 0.69314718055994531f; }
__device__ __forceinline__ float sigmoidf_(float x) { return __builtin_amdgcn_rcpf(1.0f + fexp(-x)); }
__device__ __forceinline__ float siluf_(float x) { return x * __builtin_amdgcn_rcpf(1.0f + fexp(-x)); }
__device__ __forceinline__ float geluf_(float v) {
    const float av = fabsf(v), t = __builtin_amdgcn_rcpf(av * 0.2316418882f + 1.0f);
    float q = t * 0.5307027145f + (-0.7265760135f); q = q * t + 0.7107068705f; q = q * t + (-0.142248368f); q = q * t + 0.127414796f; q = q * t;
    const float e = __builtin_amdgcn_exp2f((v * v) * (-0.72134752044f));
    const float m = v * (q * e);
    return v < 0.f ? m : v - m;
}
__device__ __forceinline__ int otid() { int t = threadIdx.x; asm volatile("" : "+v"(t)); return t; }
__device__ __forceinline__ float wave_sum(float v) {
#pragma unroll
    for (int m = 32; m >= 1; m >>= 1) v += __shfl_xor(v, m, 64);
    return v;
}

__device__ __forceinline__ void transpose_W(const float* __restrict__ W, bf16_t* __restrict__ Wt, int K, int N, int gtid, int GT) {
    const int ng = (K / 8) * N;
    for (int g = gtid; g < ng; g += GT) {
        const int n = g % N, k0 = (g / N) * 8;
        unsigned o[4];
#pragma unroll
        for (int j = 0; j < 4; ++j) o[j] = pack2(W[(size_t)(k0 + 2 * j) * N + n], W[(size_t)(k0 + 2 * j + 1) * N + n]);
        *(uint4*)(Wt + (size_t)n * K + k0) = make_uint4(o[0], o[1], o[2], o[3]);
    }
}
__device__ __forceinline__ void pack_BT(const float* __restrict__ Wt, bf16_t* __restrict__ Wp, int K, int N, int gtid, int GT) {
    const int KT = K / 32;
    const int ngrp = KT * (N / 16) * 64;
    for (int grp = gtid; grp < ngrp; grp += GT) {
        const int l = grp & 63, tile = grp >> 6;
        const int kt = tile % KT, nt = tile / KT;
        const int k0 = kt * 32 + 8 * (l >> 4), n = nt * 16 + (l & 15);
        const float* s = Wt + (size_t)n * K + k0;
        unsigned o[4];
#pragma unroll
        for (int j = 0; j < 4; ++j) o[j] = pack2(s[2 * j], s[2 * j + 1]);
        *(uint4*)(Wp + (size_t)grp * 8) = make_uint4(o[0], o[1], o[2], o[3]);
    }
}
__device__ __forceinline__ void cvt_table_fp8(const float* __restrict__ src, unsigned char* __restrict__ dst, float* __restrict__ inv, int gw, int GW, int lane) {
    for (int row = gw; row < 16384; row += GW) {
        const float4* s = (const float4*)(src + (size_t)row * 1024) + lane * 4;
        const float4 a0 = s[0], a1 = s[1], a2 = s[2], a3 = s[3];
        float m = fmaxf(fmaxf(fmaxf(fabsf(a0.x), fabsf(a0.y)), fmaxf(fabsf(a0.z), fabsf(a0.w))), fmaxf(fmaxf(fabsf(a1.x), fabsf(a1.y)), fmaxf(fabsf(a1.z), fabsf(a1.w))));
        m = fmaxf(m, fmaxf(fmaxf(fmaxf(fabsf(a2.x), fabsf(a2.y)), fmaxf(fabsf(a2.z), fabsf(a2.w))), fmaxf(fmaxf(fabsf(a3.x), fabsf(a3.y)), fmaxf(fabsf(a3.z), fabsf(a3.w)))));
#pragma unroll
        for (int o = 32; o >= 1; o >>= 1) m = fmaxf(m, __shfl_xor(m, o, 64));
        const float sc = (m > 0.f) ? exp2f(floorf(log2f(384.f / m))) : 1.f;
        int w0 = 0, w1 = 0, w2 = 0, w3 = 0;
        w0 = __builtin_amdgcn_cvt_pk_fp8_f32(a0.x * sc, a0.y * sc, w0, false); w0 = __builtin_amdgcn_cvt_pk_fp8_f32(a0.z * sc, a0.w * sc, w0, true);
        w1 = __builtin_amdgcn_cvt_pk_fp8_f32(a1.x * sc, a1.y * sc, w1, false); w1 = __builtin_amdgcn_cvt_pk_fp8_f32(a1.z * sc, a1.w * sc, w1, true);
        w2 = __builtin_amdgcn_cvt_pk_fp8_f32(a2.x * sc, a2.y * sc, w2, false); w2 = __builtin_amdgcn_cvt_pk_fp8_f32(a2.z * sc, a2.w * sc, w2, true);
        w3 = __builtin_amdgcn_cvt_pk_fp8_f32(a3.x * sc, a3.y * sc, w3, false); w3 = __builtin_amdgcn_cvt_pk_fp8_f32(a3.z * sc, a3.w * sc, w3, true);
        *(int4*)(dst + ((size_t)(lane >> 3) * 16384 + row) * 128 + (lane & 7) * 16) = make_int4(w0, w1, w2, w3);
        if (lane == 0) inv[row] = 1.0f / sc;
    }
}

__device__ __forceinline__ void phase_prep(const Params& p, unsigned char* lds) {
    const int tid = otid(), bid = blockIdx.x, nb = gridDim.x;
    const int lane = tid & 63, wave = tid >> 6;
    const int gtid = bid * NT + tid, GT = nb * NT;
    unsigned char* ws = p.ws;
    {
        const float* c = p.in[1]; const float* aw = p.in[2]; const float* ab = p.in[3];
        float* modp = (float*)(ws + OFF_MODP);
        float* red = (float*)lds;
        for (int item = bid; item < 384; item += nb) {
            const int cg = item % 96, kc = item / 96;
            const int col = cg * 64 + lane;
            float a0 = 0.f, a1 = 0.f;
            const int k0 = kc * 256 + wave * 32;
#pragma unroll 8
            for (int k = k0; k < k0 + 32; ++k) {
                const float w = aw[(size_t)k * 6144 + col];
                a0 += siluf_(c[k]) * w; a1 += siluf_(c[1024 + k]) * w;
            }
            red[(wave * 2 + 0) * 64 + lane] = a0; red[(wave * 2 + 1) * 64 + lane] = a1;
            __syncthreads();
            if (tid < 128) {
                const int b = tid >> 6, l = tid & 63;
                float s = (kc == 0) ? ab[cg * 64 + l] : 0.f;
                for (int w = 0; w < NWAVE; ++w) s += red[(w * 2 + b) * 64 + l];
                modp[(kc * 2 + b) * 6144 + cg * 64 + l] = s;
            }
            __syncthreads();
        }
    }
    {
        const float* lbin = p.in[8]; float* lb = (float*)(ws + OFF_LB);
        for (int i = gtid; i < 512; i += GT) {
            const float a = lbin[i], b = lbin[512 + i], m = fmaxf(a, b);
            const float ea = expf(a - m), eb = expf(b - m);
            lb[i] = ea / (ea + eb);
        }
    }
    {
        const float* are = p.in[10]; const float* aim = p.in[11]; const float* ldt = p.in[12];
        const float* bre = p.in[13]; const float* bim = p.in[14];
        float* AB = (float*)(ws + OFF_S5AB); float* BBR = (float*)(ws + OFF_S5BB); float* BBI = BBR + 32 * 64 * 16;
        for (int i = gtid; i < 2048; i += GT) {
            const int g = i >> 6;
            const double ar = are[i], ai = aim[i], dt = exp((double)ldt[g]);
            const double mag = exp(ar * dt), abr = mag * cos(ai * dt), abi = mag * sin(ai * dt);
            const double den = ar * ar + ai * ai, nr = abr - 1.0, ni = abi;
            const double cr = (nr * ar + ni * ai) / den, ci = (ni * ar - nr * ai) / den;
            const double magL = exp(ar * dt * (double)S5_SEG);
            AB[i] = (float)abr; AB[2048 + i] = (float)abi;
            AB[4096 + i] = (float)(magL * cos(ai * dt * (double)S5_SEG)); AB[6144 + i] = (float)(magL * sin(ai * dt * (double)S5_SEG));
            for (int h = 0; h < 16; ++h) {
                const double br = bre[i * 16 + h], bi = bim[i * 16 + h];
                BBR[i * 16 + h] = (float)(cr * br - ci * bi);
                BBI[i * 16 + h] = (float)(cr * bi + ci * br);
            }
        }
    }
    transpose_W(p.in[6], (bf16_t*)(ws + OFF_WIN), 1024, 2560, gtid, GT);
    transpose_W(p.in[7], (bf16_t*)(ws + OFF_WOUT), 1024, 1024, gtid, GT);
    transpose_W(p.in[18], (bf16_t*)(ws + OFF_WGLU), 512, 512, gtid, GT);
    transpose_W(p.in[20], (bf16_t*)(ws + OFF_WQ), 1024, 2048, gtid, GT);
    pack_BT(p.in[21], (bf16_t*)(ws + OFF_KEYS), 128, 128, gtid, GT);
    pack_BT(p.in[22], (bf16_t*)(ws + OFF_KEYS) + 128 * 128, 128, 128, gtid, GT);
    cvt_table_fp8(p.in[23], ws + OFF_UT8, (float*)(ws + OFF_ISU), bid * NWAVE + wave, nb * NWAVE, lane);
    cvt_table_fp8(p.in[24], ws + OFF_VT8, (float*)(ws + OFF_ISV), bid * NWAVE + wave, nb * NWAVE, lane);
}

template <bool MIXED>
__device__ __forceinline__ void phase_norm(const Params& p, const float* __restrict__ src, const bf16_t* __restrict__ mix, const float* __restrict__ nw, int sh_off, int sc_off, bf16_t* __restrict__ dst) {
    const int tid = otid(), lane = tid & 63, wave = tid >> 6;
    const int gw = blockIdx.x * NWAVE + wave, GW = gridDim.x * NWAVE;
    const float* mod = (const float*)(p.ws + OFF_MOD);
    const float* modp = (const float*)(p.ws + OFF_MODP);
    if (!MIXED) {
        float* modw = (float*)(p.ws + OFF_MOD);
        for (int i = blockIdx.x * NT + tid; i < 2 * 6144; i += gridDim.x * NT) modw[i] = (modp[i] + modp[12288 + i]) + (modp[2 * 12288 + i] + modp[3 * 12288 + i]);
    }
    for (int b = 0; b < BATCH; ++b) {
        float4 fa[4], fs[4];
#pragma unroll
        for (int j = 0; j < 4; ++j) {
            const int c4 = j * 64 + lane;
            const float4 w = ((const float4*)nw)[c4];
            float4 sc, shv;
            if (!MIXED) {
                const float4* q0 = (const float4*)(modp + b * 6144);
                const float4 s0 = q0[sc_off / 4 + c4], s1 = q0[12288 / 4 + sc_off / 4 + c4], s2 = q0[2 * 12288 / 4 + sc_off / 4 + c4], s3 = q0[3 * 12288 / 4 + sc_off / 4 + c4];
                const float4 h0 = q0[sh_off / 4 + c4], h1 = q0[12288 / 4 + sh_off / 4 + c4], h2 = q0[2 * 12288 / 4 + sh_off / 4 + c4], h3 = q0[3 * 12288 / 4 + sh_off / 4 + c4];
                sc = make_float4((s0.x + s1.x) + (s2.x + s3.x), (s0.y + s1.y) + (s2.y + s3.y), (s0.z + s1.z) + (s2.z + s3.z), (s0.w + s1.w) + (s2.w + s3.w));
                shv = make_float4((h0.x + h1.x) + (h2.x + h3.x), (h0.y + h1.y) + (h2.y + h3.y), (h0.z + h1.z) + (h2.z + h3.z), (h0.w + h1.w) + (h2.w + h3.w));
            } else {
                sc = ((const float4*)(mod + b * 6144 + sc_off))[c4];
                shv = ((const float4*)(mod + b * 6144 + sh_off))[c4];
            }
            fs[j] = shv;
            fa[j] = make_float4(w.x * (1.f + sc.x), w.y * (1.f + sc.y), w.z * (1.f + sc.z), w.w * (1.f + sc.w));
        }
        for (int r = gw; r < SEQ; r += GW) {
            const size_t row = (size_t)b * SEQ + r;
            const float4* xr = (const float4*)(src + row * D);
            float4 v[4];
            float ss = 0.f;
#pragma unroll
            for (int j = 0; j < 4; ++j) {
                v[j] = xr[j * 64 + lane];
                if (MIXED) {
                    const uint2 m = *(const uint2*)(mix + row * D + (size_t)(j * 64 + lane) * 4);
                    const float4 g1 = ((const float4*)(mod + b * 6144 + 2048))[j * 64 + lane];
                    v[j].x += g1.x * bflo(m.x); v[j].y += g1.y * bfhi(m.x); v[j].z += g1.z * bflo(m.y); v[j].w += g1.w * bfhi(m.y);
                }
                ss += v[j].x * v[j].x + v[j].y * v[j].y + v[j].z * v[j].z + v[j].w * v[j].w;
            }
            ss = wave_sum(ss);
            const float rstd = rsqrtf(ss * (1.0f / D) + EPS);
#pragma unroll
            for (int j = 0; j < 4; ++j) {
                const float o0 = v[j].x * rstd * fa[j].x + fs[j].x, o1 = v[j].y * rstd * fa[j].y + fs[j].y;
                const float o2 = v[j].z * rstd * fa[j].z + fs[j].z, o3 = v[j].w * rstd * fa[j].w + fs[j].w;
                *(uint2*)(dst + row * D + (size_t)(j * 64 + lane) * 4) = make_uint2(pack2(o0, o1), pack2(o2, o3));
            }
        }
    }
}

namespace pg8 {
#define PG8_LAS __attribute__((address_space(3)))
typedef unsigned short bf16_t;
typedef short bf16x8 __attribute__((ext_vector_type(8)));
typedef float f32x4 __attribute__((ext_vector_type(4)));
typedef unsigned u32x4 __attribute__((ext_vector_type(4)));
constexpr int BM = 256, BK = 64, HALF = 128, HTB = HALF * BK * 2  , STAGE_BYTES = 8 * HTB, NXCD = 8, WGM = 8;

__host__ __device__ __forceinline__ int lds_byte(int r, int c) { const int st = (r >> 4) * 2 + (c >> 5), rr = r & 15, cc = c & 31, ob = rr * 64 + cc * 2; return st * 1024 + (ob ^ (((ob >> 9) & 1) << 5)); }
__host__ __device__ __forceinline__ void stage_rc(int b, int& R, int& C) { const int st = b / 1024, sb = b % 1024, swz = sb ^ (((sb >> 9) & 1) << 5); R = (st >> 1) * 16 + swz / 64; C = (st & 1) * 32 + (swz % 64) / 2; }
__host__ __device__ __forceinline__ int perm32(int rho) { const int n = rho >> 4, i = rho & 15; return 8 * (i >> 2) + 4 * n + (i & 3); }

struct Unit { int pm, pn; };
struct Gemm { const bf16_t* A; const bf16_t* Bt; int M, N, K; };

struct StaticOrder {
    int nM, nN, nwg, G, c;
    __host__ __device__ void init(int M, int N, int G_, int c_) { nM = M / BM; nN = N / BM; nwg = nM * nN; G = G_; c = c_; }
    __host__ __device__ bool next(int i, Unit& u) const {
        const long L = (long)i * G + c; if (L >= nwg) return false;
        int wgid = (int)L; { const int q = nwg / NXCD, r = nwg % NXCD, xcd = wgid % NXCD, off = wgid / NXCD; wgid = (xcd < r ? xcd * (q + 1) : r * (q + 1) + (xcd - r) * q) + off; }
        const int nig = WGM * nN, gid = wgid / nig, fm = gid * WGM, gsz = (nM - fm) < WGM ? (nM - fm) : WGM;
        u.pm = fm + ((wgid % nig) % gsz); u.pn = (wgid % nig) / gsz; return true;
    }
    __device__ __forceinline__ void a_ready(const Unit&) const {}
    __device__ __forceinline__ void done(const Unit&) const {}
};
__device__ __forceinline__ unsigned cvt_pk_bf16(float lo, float hi) { unsigned r; asm volatile("v_cvt_pk_bf16_f32 %0, %1, %2" : "=v"(r) : "v"(lo), "v"(hi)); return r; }
typedef float f32x2 __attribute__((ext_vector_type(2)));
__device__ __forceinline__ f32x2 gelu_pk(f32x2 v) {
    const f32x2 av = __builtin_elementwise_abs(v), d = av * 0.2316418882f + 1.0f;
    f32x2 t; t.x = __builtin_amdgcn_rcpf(d.x); t.y = __builtin_amdgcn_rcpf(d.y);
    f32x2 q = t * 0.5307027145f + (-0.7265760135f); q = q * t + 0.7107068705f; q = q * t + (-0.142248368f); q = q * t + 0.127414796f; q = q * t;
    const f32x2 s = (v * v) * (-0.72134752044f);
    f32x2 e; e.x = __builtin_amdgcn_exp2f(s.x); e.y = __builtin_amdgcn_exp2f(s.y);
    const f32x2 m = v * (q * e), r = v - m;
    f32x2 o; o.x = v.x < 0.f ? m.x : r.x; o.y = v.y < 0.f ? m.y : r.y; return o;
}
template <int ACT  > struct EpiBf16 {
    static constexpr bool PERM = true, AFTER_DRAIN = false;
    bf16_t* O; int ldc; const float* bias; int split_cols; size_t split_stride;
    __device__ __forceinline__ void operator()(const f32x4 (&acc)[2][2][4][2], const Unit& u, int wr, int wc, int fr, int fq) const {
        const int row0 = u.pm * BM + wr * 64 + fr; int colt = u.pn * BM; bf16_t* base = O;
        if (split_cols) { const int t = colt / split_cols; base += (size_t)t * split_stride; colt -= t * split_cols; }
        const int col0 = colt + wc * 32 + 8 * fq, bcol0 = u.pn * BM + wc * 32 + 8 * fq;
        f32x4 bv[2][2];
#pragma unroll
        for (int bj = 0; bj < 2; ++bj)
#pragma unroll
            for (int n = 0; n < 2; ++n) bv[bj][n] = bias ? *(const f32x4*)(bias + bcol0 + bj * HALF + 4 * n) : (f32x4){0.f, 0.f, 0.f, 0.f};
#pragma unroll
        for (int ai = 0; ai < 2; ++ai)
#pragma unroll
            for (int m = 0; m < 4; ++m) { bf16_t* rowp = base + (size_t)(row0 + ai * HALF + m * 16) * ldc + col0;
#pragma unroll
                for (int bj = 0; bj < 2; ++bj) { f32x4 v0 = acc[ai][bj][m][0] + bv[bj][0], v1 = acc[ai][bj][m][1] + bv[bj][1];
                    if (ACT == 1) { f32x2 a = gelu_pk((f32x2){v0[0], v0[1]}), b = gelu_pk((f32x2){v0[2], v0[3]}), c = gelu_pk((f32x2){v1[0], v1[1]}), d = gelu_pk((f32x2){v1[2], v1[3]});
                        v0 = (f32x4){a.x, a.y, b.x, b.y}; v1 = (f32x4){c.x, c.y, d.x, d.y}; }
                    if (ACT == 2) {
#pragma unroll
                        for (int j = 0; j < 4; ++j) { v0[j] = 0.5f * v0[j] * (1.0f + erff(v0[j] * 0.70710678f)); v1[j] = 0.5f * v1[j] * (1.0f + erff(v1[j] * 0.70710678f)); } }
                    u32x4 w; w.x = cvt_pk_bf16(v0[0], v0[1]); w.y = cvt_pk_bf16(v0[2], v0[3]); w.z = cvt_pk_bf16(v1[0], v1[1]); w.w = cvt_pk_bf16(v1[2], v1[3]);
                    *(u32x4*)(rowp + bj * HALF) = w; } }
    }
};

template <class Epi, class Sched, bool STAMP = false>
__device__ __forceinline__ void gemm_phase(PG8_LAS unsigned char* lds, const Gemm g, const Sched& S, const Epi& E, unsigned long long* stamps) {
    int tid_ = threadIdx.x; asm volatile("" : "+v"(tid_));
    const int tid = tid_, wid = __builtin_amdgcn_readfirstlane(tid >> 6), lane = tid & 63, wr = wid >> 2, wc = wid & 3, fr = lane & 15, fq = lane >> 4;
    const int K = g.K, nt = K / BK;
    int ts_lo = 0, ts_hi = 0, nts = 0; const unsigned long long rt_entry = 0ull;
#define PG8_STAMP() do { if (STAMP && wid == 0 && nts < 64) { const unsigned long long _c = (unsigned long long)clock64(); \
        ts_lo = (lane == nts) ? (int)(unsigned)_c : ts_lo; ts_hi = (lane == nts) ? (int)(unsigned)(_c >> 32) : ts_hi; ++nts; } } while (0)
    PG8_STAMP();
    unsigned voffA[2], voffB[2];
#pragma unroll
    for (int i = 0; i < 2; ++i) { int R, C; stage_rc(tid * 16 + i * 8192, R, C); const int Rb = Epi::PERM ? ((R & ~31) + perm32(R & 31)) : R;
        voffA[i] = (unsigned)(R * K + C) * 2u; voffB[i] = (unsigned)(Rb * K + C) * 2u; }
    const size_t kstep = (size_t)(BK * 2);
    const size_t hstep = (size_t)HALF * K * 2;
    const size_t tstep = 2 * hstep;
    const unsigned ldsw = (unsigned)wid * 1024u;
    const int aoff = lds_byte(wr * 64 + fr, fq * 8), boff = lds_byte(wc * 32 + fr, fq * 8);
#define PG8_SA(b, h) (((b) * 2 + (h)) * HTB)
#define PG8_SB(b, h) ((4 + (b) * 2 + (h)) * HTB)
#define PG8_STAGE(bufoff, gbase, voff) do { _Pragma("unroll") for (int _i = 0; _i < 2; ++_i) \
        __builtin_amdgcn_global_load_lds((const unsigned*)((const char*)(gbase) + (voff)[_i]), (PG8_LAS unsigned*)(lds + (bufoff) + ldsw + _i * 8192), 16, 0, 0); } while (0)
#define PG8_LDA(dst, b, h) do { _Pragma("unroll") for (int m = 0; m < 4; ++m) _Pragma("unroll") for (int k = 0; k < 2; ++k) dst[m][k] = *(const PG8_LAS bf16x8*)(lds + PG8_SA(b, h) + aoff + m * 2048 + k * 1024); } while (0)
#define PG8_LDB(dst, b, h) do { _Pragma("unroll") for (int n = 0; n < 2; ++n) _Pragma("unroll") for (int k = 0; k < 2; ++k) dst[n][k] = *(const PG8_LAS bf16x8*)(lds + PG8_SB(b, h) + boff + n * 2048 + k * 1024); } while (0)
#define PG8_MMA(ai, bj, At, Bt) do { __builtin_amdgcn_s_setprio(1); _Pragma("unroll") for (int m = 0; m < 4; ++m) _Pragma("unroll") for (int n = 0; n < 2; ++n) _Pragma("unroll") for (int k = 0; k < 2; ++k) \
        acc[ai][bj][m][n] = __builtin_amdgcn_mfma_f32_16x16x32_bf16(Bt[n][k], At[m][k], acc[ai][bj][m][n], 0, 0, 0); __builtin_amdgcn_s_setprio(0); } while (0)
#define PG8_WAIT_V(n) asm volatile("s_waitcnt vmcnt(" #n ")" ::: "memory")
#define PG8_WAIT_L(n) asm volatile("s_waitcnt lgkmcnt(" #n ")" ::: "memory")
#define PG8_BAR __builtin_amdgcn_s_barrier()
#define PG8_SCHED __builtin_amdgcn_sched_barrier(0)
    Unit cur, nxt; int ui = 0;
    if (!S.next(0, cur)) return;
    f32x4 acc[2][2][4][2];
#pragma unroll
    for (int a = 0; a < 2; ++a)
#pragma unroll
        for (int b = 0; b < 2; ++b)
#pragma unroll
            for (int m = 0; m < 4; ++m)
#pragma unroll
                for (int n = 0; n < 2; ++n) acc[a][b][m][n] = (f32x4){0.f, 0.f, 0.f, 0.f};
    bf16x8 At[4][2], B0[2][2], B1[2][2];
    const char* cA = (const char*)g.A + (size_t)cur.pm * tstep; const char* cB = (const char*)g.Bt + (size_t)cur.pn * tstep;
    S.a_ready(cur);
    PG8_STAGE(PG8_SB(0, 0), cB, voffB); PG8_STAGE(PG8_SA(0, 0), cA, voffA); PG8_STAGE(PG8_SB(0, 1), cB + hstep, voffB); PG8_STAGE(PG8_SA(0, 1), cA + hstep, voffA);
    if (wr == 1) PG8_BAR;
    PG8_WAIT_V(4); PG8_BAR;
    PG8_STAGE(PG8_SB(1, 0), cB + kstep, voffB); PG8_STAGE(PG8_SA(1, 0), cA + kstep, voffA); PG8_STAGE(PG8_SB(1, 1), cB + hstep + kstep, voffB);
    PG8_WAIT_V(6); PG8_BAR;
    PG8_STAMP();
    for (;;) {
        const bool has_next = S.next(ui + 1, nxt);
        const char* nA = has_next ? (const char*)g.A + (size_t)nxt.pm * tstep : cA; const char* nB = has_next ? (const char*)g.Bt + (size_t)nxt.pn * tstep : cB;
        for (int t = 0; t < nt; t += 2) {
            const bool last = (t == nt - 2);
            const char* a1 = cA + (size_t)(t + 1) * kstep;
            const char* a2 = last ? nA : cA + (size_t)(t + 2) * kstep; const char* b2 = last ? nB : cB + (size_t)(t + 2) * kstep;
            const char* a3 = a2 + kstep; const char* b3 = b2 + kstep;
            if (last && has_next) S.a_ready(nxt);
            PG8_LDB(B0, 0, 0); PG8_SCHED; PG8_LDA(At, 0, 0); PG8_STAGE(PG8_SA(1, 1), a1 + hstep, voffA);
            PG8_WAIT_L(8); PG8_BAR; PG8_WAIT_L(0); PG8_MMA(0, 0, At, B0); PG8_BAR; PG8_SCHED;
            PG8_LDB(B1, 0, 1); PG8_STAGE(PG8_SB(0, 0), b2, voffB);
            PG8_BAR; PG8_WAIT_L(0); PG8_MMA(0, 1, At, B1); PG8_BAR;
            PG8_LDA(At, 0, 1); PG8_STAGE(PG8_SA(0, 0), a2, voffA);
            PG8_BAR; PG8_WAIT_L(0); PG8_MMA(1, 0, At, B0); PG8_BAR; PG8_SCHED;
            PG8_STAGE(PG8_SB(0, 1), b2 + hstep, voffB);
            PG8_WAIT_V(6); PG8_BAR; PG8_MMA(1, 1, At, B1); PG8_BAR;
            PG8_LDB(B0, 1, 0); PG8_SCHED; PG8_LDA(At, 1, 0); PG8_STAGE(PG8_SA(0, 1), a2 + hstep, voffA);
            PG8_WAIT_L(8); PG8_BAR; PG8_WAIT_L(0); PG8_MMA(0, 0, At, B0); PG8_BAR; PG8_SCHED;
            PG8_LDB(B1, 1, 1); PG8_STAGE(PG8_SB(1, 0), b3, voffB);
            PG8_BAR; PG8_WAIT_L(0); PG8_MMA(0, 1, At, B1); PG8_BAR;
            PG8_LDA(At, 1, 1); PG8_STAGE(PG8_SA(1, 0), a3, voffA);
            PG8_BAR; PG8_WAIT_L(0); PG8_MMA(1, 0, At, B0); PG8_BAR; PG8_SCHED;
            PG8_STAGE(PG8_SB(1, 1), b3 + hstep, voffB);
            PG8_WAIT_V(6); PG8_BAR; PG8_MMA(1, 1, At, B1); PG8_BAR;
        }
        PG8_STAMP();
        if constexpr (!Epi::AFTER_DRAIN) { E(acc, cur, wr, wc, fr, fq); S.done(cur); }
        PG8_STAMP();
        if (!has_next) break;
#pragma unroll
        for (int a = 0; a < 2; ++a)
#pragma unroll
            for (int b = 0; b < 2; ++b)
#pragma unroll
                for (int m = 0; m < 4; ++m)
#pragma unroll
                    for (int n = 0; n < 2; ++n) acc[a][b][m][n] = (f32x4){0.f, 0.f, 0.f, 0.f};
        cur = nxt; cA = nA; cB = nB; ++ui;
    }
    PG8_WAIT_V(0);
    if (wr == 0) PG8_BAR;
    PG8_BAR;
    if constexpr (Epi::AFTER_DRAIN) { E.fused(acc, cur, wr, wc, fr, fq, lds, wid, lane); S.done(cur); }
    PG8_STAMP();
    if (STAMP && wid == 0) { stamps[lane] = lane < nts ? (((unsigned long long)(unsigned)ts_hi << 32) | (unsigned)ts_lo) : 0ull;
        if (lane == 62) stamps[62] = rt_entry; }
#undef PG8_STAMP
#undef PG8_SA
#undef PG8_SB
#undef PG8_STAGE
#undef PG8_LDA
#undef PG8_LDB
#undef PG8_MMA
#undef PG8_WAIT_V
#undef PG8_WAIT_L
#undef PG8_BAR
#undef PG8_SCHED
}
}

struct EpiGlu {
    static constexpr bool PERM = true, AFTER_DRAIN = false;
    const bf16_t* YG; const float* bias; bf16_t* OC;
    __device__ __forceinline__ void operator()(const pg8::f32x4 (&acc)[2][2][4][2], const pg8::Unit& u, int wr, int wc, int fr, int fq) const {
        const int row0 = u.pm * 256 + wr * 64 + fr, col0 = u.pn * 256 + wc * 32 + 8 * fq;
#pragma unroll
        for (int ai = 0; ai < 2; ++ai)
#pragma unroll
            for (int m = 0; m < 4; ++m) {
                const size_t row = (size_t)(row0 + ai * 128 + m * 16);
#pragma unroll
                for (int bj = 0; bj < 2; ++bj) {
                    const int col = col0 + bj * 128;
                    const uint4 yv = *(const uint4*)(YG + row * 512 + col);
                    const float4 b0 = *(const float4*)(bias + col), b1 = *(const float4*)(bias + col + 4);
                    const pg8::f32x4 v0 = acc[ai][bj][m][0], v1 = acc[ai][bj][m][1];
                    const float o0 = bflo(yv.x) * sigmoidf_(v0[0] + b0.x), o1 = bfhi(yv.x) * sigmoidf_(v0[1] + b0.y);
                    const float o2 = bflo(yv.y) * sigmoidf_(v0[2] + b0.z), o3 = bfhi(yv.y) * sigmoidf_(v0[3] + b0.w);
                    const float o4 = bflo(yv.z) * sigmoidf_(v1[0] + b1.x), o5 = bfhi(yv.z) * sigmoidf_(v1[1] + b1.y);
                    const float o6 = bflo(yv.w) * sigmoidf_(v1[2] + b1.z), o7 = bfhi(yv.w) * sigmoidf_(v1[3] + b1.w);
                    *(uint4*)(OC + row * 1024 + 512 + col) = make_uint4(pack2(o0, o1), pack2(o2, o3), pack2(o4, o5), pack2(o6, o7));
                }
            }
    }
};
template <class Epi>
__device__ __forceinline__ void gemm_run(unsigned char* lds, const bf16_t* A, const bf16_t* Bt, int M, int N, int K, const Epi& E) {
    pg8::Gemm g{A, Bt, M, N, K};
    pg8::StaticOrder S; S.init(M, N, (int)gridDim.x, (int)blockIdx.x);
    pg8::gemm_phase<Epi, pg8::StaticOrder, false>((PG8_LAS unsigned char*)lds, g, S, E, nullptr);
}

constexpr int HQ = 136;
constexpr int HV = 72;
constexpr int HL = 132;
constexpr int HG_L = 0, HG_OFFS = 33792, HG_RS = 35840, HG_QT = 36864, HG_KT = 54272, HG_VT = 71680, HG_ST = 90112, HG_SC = 124928;
__device__ __forceinline__ unsigned rawpack(bf16_t a, bf16_t b) { return (unsigned)a | ((unsigned)b << 16); }
struct HgIn { u32x2_t q[4], z[4], v[4]; };
__device__ __forceinline__ void hg_load(const Params& p, int unit, int tid, HgIn& in, bool want_q) {
    const bf16_t* PROJ = (const bf16_t*)(p.ws + OFF_PROJ);
    const int c = unit & 255, h = (unit >> 8) & 3, b = unit >> 10;
    const int tok0 = b * SEQ + c * 64;
#pragma unroll
    for (int j = 0; j < 4; ++j) {
        const int e4 = tid + NT * j, t = e4 >> 5, k4 = (e4 & 31) * 4;
        const size_t base = (size_t)(tok0 + t) * INW + h * 128 + k4;
        if (want_q) in.q[j] = *(const u32x2_t*)(PROJ + base);
        in.z[j] = *(const u32x2_t*)(PROJ + base + 512);
        in.v[j] = *(const u32x2_t*)(PROJ + base + 1024);
    }
}
__device__ __forceinline__ void hg_cumsum(unsigned char* lds, const HgIn& in, const float4 l4) {
    const int tid = otid();
    float* L = (float*)(lds + HG_L); float* OFFS = (float*)(lds + HG_OFFS);
#pragma unroll
    for (int j = 0; j < 4; ++j) {
        const int e4 = tid + NT * j, t = e4 >> 5, k4 = (e4 & 31) * 4;
        const u32x2_t zz = in.z[j];
        float4 o;
        o.x = flog(1.f - (1.f - l4.x) * sigmoidf_(-bflo(zz.x))); o.y = flog(1.f - (1.f - l4.y) * sigmoidf_(-bfhi(zz.x)));
        o.z = flog(1.f - (1.f - l4.z) * sigmoidf_(-bflo(zz.y))); o.w = flog(1.f - (1.f - l4.w) * sigmoidf_(-bfhi(zz.y)));
        *(float4*)(L + t * HL + k4) = o;
    }
    __syncthreads();
    const int k = tid & 127, sg = tid >> 7;
    {
        float s = 0.f;
#pragma unroll
        for (int i = 0; i < 16; ++i) { const int t = sg * 16 + i; s += L[t * HL + k]; L[t * HL + k] = s; }
    }
    __syncthreads();
    {
        float off = 0.f;
#pragma unroll
        for (int s2 = 0; s2 < 3; ++s2) if (s2 < sg) off += L[(s2 * 16 + 15) * HL + k];
        OFFS[sg * 128 + k] = off;
    }
    __syncthreads();
}

__device__ __forceinline__ void phase_hg1(const Params& p, unsigned char* lds) {
    const int tid = otid(), lane = tid & 63, wave = tid >> 6, fr = lane & 15, fq = lane >> 4;
    const float* L = (const float*)(lds + HG_L); const float* OFFS = (const float*)(lds + HG_OFFS);
    bf16_t* VT = (bf16_t*)(lds + HG_VT); bf16_t* KET = (bf16_t*)(lds + HG_ST);
    const float* lb = (const float*)(p.ws + OFF_LB);
    bf16_t* HGS = (bf16_t*)(p.ws + OFF_HGS);
    float* DEC = (float*)(p.ws + OFF_HGDEC);
    HgIn in;
    hg_load(p, (int)blockIdx.x < 2048 ? (int)blockIdx.x : 0, tid, in, false);
    for (int unit = blockIdx.x; unit < 2048; unit += gridDim.x) {
        const int h = (unit >> 8) & 3;
        const float4 l4 = *(const float4*)(lb + h * 128 + (tid & 31) * 4);
        hg_cumsum(lds, in, l4);
#pragma unroll
        for (int j = 0; j < 4; ++j) {
            const int e4 = tid + NT * j, t = e4 >> 5, k4 = (e4 & 31) * 4;
            const u32x2_t zz = in.z[j], vv = in.v[j];
            const float4 bc = *(const float4*)(L + t * HL + k4), of = *(const float4*)(OFFS + (t >> 4) * 128 + k4);
            const float4 bl = *(const float4*)(L + 63 * HL + k4), ol = *(const float4*)(OFFS + 3 * 128 + k4);
            const float zf[4] = {bflo(zz.x), bfhi(zz.x), bflo(zz.y), bfhi(zz.y)};
            const float lv[4] = {l4.x, l4.y, l4.z, l4.w};
            const float bcv[4] = {bc.x + of.x, bc.y + of.y, bc.z + of.z, bc.w + of.w};
            const float blv[4] = {bl.x + ol.x, bl.y + ol.y, bl.z + ol.z, bl.w + ol.w};
            const bf16_t vr[4] = {(bf16_t)(vv.x & 0xffffu), (bf16_t)(vv.x >> 16), (bf16_t)(vv.y & 0xffffu), (bf16_t)(vv.y >> 16)};
#pragma unroll
            for (int i = 0; i < 4; ++i) {
                const float kk = (1.f - lv[i]) * sigmoidf_(-zf[i]);
                KET[(k4 + i) * HV + t] = f2bf(kk * fexp(blv[i] - bcv[i]));
                VT[(k4 + i) * HV + t] = vr[i];
                if (t == 63) DEC[unit * 128 + k4 + i] = fexp(blv[i]);
            }
        }
        hg_load(p, (unit + (int)gridDim.x < 2048) ? unit + (int)gridDim.x : unit, tid, in, false);
        __syncthreads();
        f32x4 acc[8];
#pragma unroll
        for (int n = 0; n < 8; ++n) acc[n] = (f32x4){0.f, 0.f, 0.f, 0.f};
#pragma unroll
        for (int kt = 0; kt < 2; ++kt) {
            const bf16x8 a = *(const bf16x8*)(KET + (wave * 16 + fr) * HV + kt * 32 + 8 * fq);
#pragma unroll
            for (int n = 0; n < 8; ++n) {
                const bf16x8 bb = *(const bf16x8*)(VT + (n * 16 + fr) * HV + kt * 32 + 8 * fq);
                acc[n] = __builtin_amdgcn_mfma_f32_16x16x32_bf16(a, bb, acc[n], 0, 0, 0);
            }
        }
#pragma unroll
        for (int n = 0; n < 8; ++n)
            *(uint2*)(HGS + (size_t)unit * 16384 + (size_t)(n * 16 + fr) * 128 + wave * 16 + 4 * fq) = make_uint2(pack2(acc[n][0], acc[n][1]), pack2(acc[n][2], acc[n][3]));
        __syncthreads();
    }
}

__device__ __forceinline__ void phase_hg2(const Params& p) {
    const int gtid = blockIdx.x * NT + otid(), GT = gridDim.x * NT;
    const bf16_t* __restrict__ HGS = (const bf16_t*)(p.ws + OFF_HGS);
    bf16_t* __restrict__ SST = (bf16_t*)(p.ws + OFF_H);
    const float* __restrict__ DEC = (const float*)(p.ws + OFF_HGDEC);
    for (int idx = gtid; idx < 8 * 16384; idx += GT) {
        const int bh = idx >> 14, kv = idx & 16383, k = kv & 127;
        float s = 0.f;
#pragma unroll 8
        for (int c = 0; c < 256; ++c) {
            const size_t unit = (size_t)bh * 256 + c;
            const float loc = bf2f(HGS[unit * 16384 + kv]);
            const float d = DEC[unit * 128 + k];
            SST[unit * 16384 + kv] = f2bf(s);
            s = d * s + loc;
        }
    }
}

__device__ __forceinline__ void phase_hg3(const Params& p, unsigned char* lds) {
    const int tid = otid(), lane = tid & 63, wave = tid >> 6, fr = lane & 15, fq = lane >> 4;
    const float* L = (const float*)(lds + HG_L); const float* OFFS = (const float*)(lds + HG_OFFS); float* RS = (float*)(lds + HG_RS);
    bf16_t* QT = (bf16_t*)(lds + HG_QT); bf16_t* KT = (bf16_t*)(lds + HG_KT); bf16_t* VT = (bf16_t*)(lds + HG_VT);
    bf16_t* ST = (bf16_t*)(lds + HG_ST); bf16_t* SC = (bf16_t*)(lds + HG_SC);
    const bf16_t* PROJ = (const bf16_t*)(p.ws + OFF_PROJ);
    const float* lb = (const float*)(p.ws + OFF_LB);
    const bf16_t* SST = (const bf16_t*)(p.ws + OFF_H);
    bf16_t* OCAT = (bf16_t*)(p.ws + OFF_OCAT);
    const float* gnw = p.in[9];
    float gn4[4];
#pragma unroll
    for (int jn = 0; jn < 4; ++jn) gn4[jn] = gnw[((wave >> 2) * 4 + jn) * 16 + fr];
    HgIn in; u32x4_t sq[4];
    {
        const int u0 = (int)blockIdx.x < 2048 ? (int)blockIdx.x : 0;
        hg_load(p, u0, tid, in, true);
#pragma unroll
        for (int j = 0; j < 4; ++j) { const int ci = tid + NT * j; sq[j] = *(const u32x4_t*)(SST + (size_t)u0 * 16384 + (ci >> 4) * 128 + (ci & 15) * 8); }
    }
    for (int unit = blockIdx.x; unit < 2048; unit += gridDim.x) {
        const int c = unit & 255, h = (unit >> 8) & 3, b = unit >> 10;
        const int tok0 = b * SEQ + c * 64;
        const float4 l4 = *(const float4*)(lb + h * 128 + (tid & 31) * 4);
        hg_cumsum(lds, in, l4);
#pragma unroll
        for (int j = 0; j < 4; ++j) {
            const int e4 = tid + NT * j, t = e4 >> 5, k4 = (e4 & 31) * 4;
            const u32x2_t qq = in.q[j], zz = in.z[j], vv = in.v[j];
            const float4 bc = *(const float4*)(L + t * HL + k4), of = *(const float4*)(OFFS + (t >> 4) * 128 + k4);
            const float qf[4] = {bflo(qq.x), bfhi(qq.x), bflo(qq.y), bfhi(qq.y)};
            const float zf[4] = {bflo(zz.x), bfhi(zz.x), bflo(zz.y), bfhi(zz.y)};
            const float lv[4] = {l4.x, l4.y, l4.z, l4.w};
            const float bcv[4] = {bc.x + of.x, bc.y + of.y, bc.z + of.z, bc.w + of.w};
            const bf16_t vr[4] = {(bf16_t)(vv.x & 0xffffu), (bf16_t)(vv.x >> 16), (bf16_t)(vv.y & 0xffffu), (bf16_t)(vv.y >> 16)};
            float qt[4], kt[4];
#pragma unroll
            for (int i = 0; i < 4; ++i) {
                const float kk = (1.f - lv[i]) * sigmoidf_(-zf[i]);
                qt[i] = siluf_(qf[i]) * 0.08838834764831845f * fexp(bcv[i]);
                kt[i] = kk * fexp(-bcv[i]);
                VT[(k4 + i) * HV + t] = vr[i];
            }
            *(uint2*)(QT + t * HQ + k4) = make_uint2(pack2(qt[0], qt[1]), pack2(qt[2], qt[3]));
            *(uint2*)(KT + t * HQ + k4) = make_uint2(pack2(kt[0], kt[1]), pack2(kt[2], kt[3]));
        }
#pragma unroll
        for (int j = 0; j < 4; ++j) { const int ci = tid + NT * j; *(u32x4_t*)(ST + (ci >> 4) * HQ + (ci & 15) * 8) = sq[j]; }
        {
            const int un = (unit + (int)gridDim.x < 2048) ? unit + (int)gridDim.x : unit;
            hg_load(p, un, tid, in, true);
#pragma unroll
            for (int j = 0; j < 4; ++j) { const int ci = tid + NT * j; sq[j] = *(const u32x4_t*)(SST + (size_t)un * 16384 + (ci >> 4) * 128 + (ci & 15) * 8); }
        }
        bf16_t gq[4][4];
#pragma unroll
        for (int r = 0; r < 4; ++r)
#pragma unroll
            for (int jn = 0; jn < 4; ++jn)
                gq[r][jn] = PROJ[(size_t)(tok0 + (wave & 3) * 16 + 4 * fq + r) * INW + 1536 + h * 128 + ((wave >> 2) * 4 + jn) * 16 + fr];
        __syncthreads();
        {
            const int mt = wave >> 1;
            bf16x8 aq[4];
#pragma unroll
            for (int kt = 0; kt < 4; ++kt) aq[kt] = *(const bf16x8*)(QT + (mt * 16 + fr) * HQ + kt * 32 + 8 * fq);
#pragma unroll
            for (int jn = 0; jn < 2; ++jn) {
                const int nt = 2 * (wave & 1) + jn;
                f32x4 acc = (f32x4){0.f, 0.f, 0.f, 0.f};
                if (nt <= mt) {
#pragma unroll
                    for (int kt = 0; kt < 4; ++kt) {
                        const bf16x8 bk = *(const bf16x8*)(KT + (nt * 16 + fr) * HQ + kt * 32 + 8 * fq);
                        acc = __builtin_amdgcn_mfma_f32_16x16x32_bf16(aq[kt], bk, acc, 0, 0, 0);
                    }
                }
#pragma unroll
                for (int r = 0; r < 4; ++r) {
                    const int t = mt * 16 + 4 * fq + r, s = nt * 16 + fr;
                    SC[t * HV + s] = f2bf((s <= t) ? acc[r] : 0.f);
                }
            }
        }
        __syncthreads();
        const int mt = wave & 3, ntb = (wave >> 2) * 4;
        f32x4 acc[4];
        {
            bf16x8 aq[4], as[2];
#pragma unroll
            for (int kt = 0; kt < 4; ++kt) aq[kt] = *(const bf16x8*)(QT + (mt * 16 + fr) * HQ + kt * 32 + 8 * fq);
#pragma unroll
            for (int kt = 0; kt < 2; ++kt) as[kt] = *(const bf16x8*)(SC + (mt * 16 + fr) * HV + kt * 32 + 8 * fq);
#pragma unroll
            for (int jn = 0; jn < 4; ++jn) {
                acc[jn] = (f32x4){0.f, 0.f, 0.f, 0.f};
                const int nt = ntb + jn;
#pragma unroll
                for (int kt = 0; kt < 4; ++kt) {
                    const bf16x8 bs = *(const bf16x8*)(ST + (nt * 16 + fr) * HQ + kt * 32 + 8 * fq);
                    acc[jn] = __builtin_amdgcn_mfma_f32_16x16x32_bf16(aq[kt], bs, acc[jn], 0, 0, 0);
                }
#pragma unroll
                for (int kt = 0; kt < 2; ++kt) {
                    const bf16x8 bv = *(const bf16x8*)(VT + (nt * 16 + fr) * HV + kt * 32 + 8 * fq);
                    acc[jn] = __builtin_amdgcn_mfma_f32_16x16x32_bf16(as[kt], bv, acc[jn], 0, 0, 0);
                }
            }
        }
        float ssq[4];
#pragma unroll
        for (int r = 0; r < 4; ++r) {
            float s = 0.f;
#pragma unroll
            for (int jn = 0; jn < 4; ++jn) s += acc[jn][r] * acc[jn][r];
            s += __shfl_xor(s, 1, 64); s += __shfl_xor(s, 2, 64); s += __shfl_xor(s, 4, 64); s += __shfl_xor(s, 8, 64);
            ssq[r] = s;
            if (fr == 0) RS[wave * 16 + 4 * fq + r] = s;
        }
        __syncthreads();
#pragma unroll
        for (int r = 0; r < 4; ++r) {
            const float tot = ssq[r] + RS[(wave ^ 4) * 16 + 4 * fq + r];
            const float rstd = rsqrtf(tot * (1.0f / 128.0f) + EPS);
            const int t = mt * 16 + 4 * fq + r;
#pragma unroll
            for (int jn = 0; jn < 4; ++jn) {
                const int v = (ntb + jn) * 16 + fr;
                OCAT[(size_t)(tok0 + t) * 1024 + h * 128 + v] = f2bf(acc[jn][r] * rstd * gn4[jn] * siluf_(bf2f(gq[r][jn])));
            }
        }
        __syncthreads();
    }
}

__device__ __forceinline__ void lds_barrier() { asm volatile("s_waitcnt lgkmcnt(0)" ::: "memory"); }
constexpr int XS = 136;
constexpr int BS = 132;
constexpr int S5_WAVE_LDS = 16 * BS * 4 + 16 * XS * 2 + 512 + 512;
template <bool FINAL>
__device__ __forceinline__ void phase_s5_scan(const Params& p, unsigned char* lds) {
    const int tid = otid(), lane = tid & 63, wave = tid >> 6, fr = lane & 15, fq = lane >> 4;
    float* BUs = (float*)(lds + wave * S5_WAVE_LDS);
    bf16_t* Xw = (bf16_t*)(lds + wave * S5_WAVE_LDS + 16 * BS * 4);
    bf16_t* U16 = Xw + 16 * XS;
    bf16_t* Y16 = U16 + 256;
    const bf16_t* PROJ = (const bf16_t*)(p.ws + OFF_PROJ);
    const float* AB = (const float*)(p.ws + OFF_S5AB);
    const float* BBR = (const float*)(p.ws + OFF_S5BB); const float* BBI = BBR + 32 * 64 * 16;
    float* END = (float*)(p.ws + OFF_S5END);
    const float* CAR = (const float*)(p.ws + OFF_S5CAR);
    bf16_t* YG = (bf16_t*)(p.ws + OFF_YG);
    const float* cre_g = p.in[15]; const float* cim_g = p.in[16]; const float* dsk = p.in[17];
    for (int item = blockIdx.x; item < 256; item += gridDim.x) {
        const int unit = item * NWAVE + wave;
        const int seg = unit & 31, g = (unit >> 5) & 31, b = unit >> 10;
        bf16x8 bbf[8];
#pragma unroll
        for (int nt = 0; nt < 8; ++nt) {
            const int pp = 8 * nt + (fr >> 1);
            const float* bs = ((fr & 1) ? BBI : BBR) + (size_t)(g * 64 + pp) * 16 + 8 * (fq & 1);
            const float4 c0 = *(const float4*)bs, c1 = *(const float4*)(bs + 4);
            const uint4 wv = (fq < 2) ? make_uint4(pack2(c0.x, c0.y), pack2(c0.z, c0.w), pack2(c1.x, c1.y), pack2(c1.z, c1.w)) : make_uint4(0u, 0u, 0u, 0u);
            bbf[nt] = __builtin_bit_cast(bf16x8, wv);
        }
        bf16x8 cb[4];
        float dskh = 0.f;
        if (FINAL) {
#pragma unroll
            for (int kt = 0; kt < 4; ++kt) {
                const float* cs = ((kt < 2) ? cre_g : cim_g) + (size_t)(g * 16 + fr) * 64 + (kt & 1) * 32 + 8 * fq;
                const float sg = (kt < 2) ? 1.f : -1.f;
                const float4 c0 = *(const float4*)cs, c1 = *(const float4*)(cs + 4);
                const uint4 wv = make_uint4(pack2(sg * c0.x, sg * c0.y), pack2(sg * c0.z, sg * c0.w), pack2(sg * c1.x, sg * c1.y), pack2(sg * c1.z, sg * c1.w));
                cb[kt] = __builtin_bit_cast(bf16x8, wv);
            }
            dskh = dsk[g * 16 + fr];
        }
        const float are = AB[g * 64 + lane], aim = AB[2048 + g * 64 + lane];
        float xr = 0.f, xi = 0.f;
        const size_t sidx = (((size_t)b * 32 + g) * 32 + seg) * 128 + lane * 2;
        if (FINAL) { xr = CAR[sidx]; xi = CAR[sidx + 1]; }
        const int tok_seg = b * SEQ + seg * S5_SEG;
        const bf16_t* ubase = PROJ + (size_t)(tok_seg + fr) * INW + 2048 + g * 16 + 8 * (fq & 1);
        u32x4_t ua = *(const u32x4_t*)ubase, ub = *(const u32x4_t*)(ubase + (size_t)16 * INW);
        for (int tile = 0; tile < S5_SEG / 16; ++tile) {
            const int tokbase = tok_seg + tile * 16;
            if (FINAL && tile > 0 && lane < 32) *(u32x4_t*)(YG + (size_t)(tokbase - 16 + (lane >> 1)) * 512 + g * 16 + 8 * (lane & 1)) = *(const u32x4_t*)(Y16 + (lane >> 1) * 16 + 8 * (lane & 1));
            const u32x4_t uz = {0u, 0u, 0u, 0u};
            const bf16x8 af = __builtin_bit_cast(bf16x8, (fq < 2) ? ua : uz);
            if (FINAL && fq < 2) *(u32x4_t*)(U16 + fr * 16 + 8 * fq) = ua;
            ua = ub;
            if (tile + 2 < S5_SEG / 16) ub = *(const u32x4_t*)(ubase + (size_t)(tile + 2) * 16 * INW);
#pragma unroll
            for (int nt = 0; nt < 8; ++nt) {
                f32x4 acc = (f32x4){0.f, 0.f, 0.f, 0.f};
                acc = __builtin_amdgcn_mfma_f32_16x16x32_bf16(af, bbf[nt], acc, 0, 0, 0);
#pragma unroll
                for (int r = 0; r < 4; ++r) BUs[(4 * fq + r) * BS + nt * 16 + fr] = acc[r];
            }
            lds_barrier();
            float2 bu[16];
#pragma unroll
            for (int t = 0; t < 16; ++t) bu[t] = *(const float2*)(BUs + t * BS + 2 * lane);
            __builtin_amdgcn_sched_barrier(0);
#pragma unroll
            for (int t = 0; t < 16; ++t) {
                const float nxr = are * xr - aim * xi + bu[t].x;
                const float nxi = are * xi + aim * xr + bu[t].y;
                xr = nxr; xi = nxi;
                if (FINAL) { Xw[t * XS + lane] = f2bf(xr); Xw[t * XS + 64 + lane] = f2bf(xi); }
            }
            lds_barrier();
            if (FINAL) {
                f32x4 acc = (f32x4){0.f, 0.f, 0.f, 0.f};
#pragma unroll
                for (int kt = 0; kt < 4; ++kt) {
                    const bf16x8 a = *(const bf16x8*)(Xw + fr * XS + kt * 32 + 8 * fq);
                    acc = __builtin_amdgcn_mfma_f32_16x16x32_bf16(a, cb[kt], acc, 0, 0, 0);
                }
#pragma unroll
                for (int r = 0; r < 4; ++r) {
                    const int tl = 4 * fq + r;
                    Y16[tl * 16 + fr] = f2bf(geluf_(acc[r] + dskh * bf2f(U16[tl * 16 + fr])));
                }
                lds_barrier();
            }
        }
        if (FINAL) {
            if (lane < 32) *(u32x4_t*)(YG + (size_t)(tok_seg + S5_SEG - 16 + (lane >> 1)) * 512 + g * 16 + 8 * (lane & 1)) = *(const u32x4_t*)(Y16 + (lane >> 1) * 16 + 8 * (lane & 1));
            lds_barrier();
        }
        if (!FINAL) { END[sidx] = xr; END[sidx + 1] = xi; }
    }
}
__device__ __forceinline__ void phase_s5_carry(const Params& p) {
    const int gtid = blockIdx.x * NT + otid(), GT = gridDim.x * NT;
    const float* AB = (const float*)(p.ws + OFF_S5AB);
    const float* END = (const float*)(p.ws + OFF_S5END);
    float* CAR = (float*)(p.ws + OFF_S5CAR);
    for (int idx = gtid; idx < 4096; idx += GT) {
        const int pp = idx & 63, g = (idx >> 6) & 31, b = idx >> 11;
        const float ar = AB[4096 + g * 64 + pp], ai = AB[6144 + g * 64 + pp];
        float cr = 0.f, ci = 0.f;
        for (int seg = 0; seg < S5_NSEG; ++seg) {
            const size_t sidx = (((size_t)b * 32 + g) * 32 + seg) * 128 + pp * 2;
            CAR[sidx] = cr; CAR[sidx + 1] = ci;
            const float er = END[sidx], ei = END[sidx + 1];
            const float nr = ar * cr - ai * ci + er, ni = ar * ci + ai * cr + ei;
            cr = nr; ci = ni;
        }
    }
}

__device__ __forceinline__ void sort16_desc(float (&v)[16]) {
    constexpr int NA[60] = {0, 1, 2, 3, 4, 5, 7, 9,  0, 1, 2, 3, 6, 8, 10, 11,  0, 2, 4, 6, 7, 10, 12, 14,  0, 1, 4, 5, 6, 8, 12, 13,  1, 3, 4, 5, 8, 9, 13,  1, 2, 5, 7, 9, 11,  2, 3, 9, 11,  3, 6, 7, 10,  3, 5, 7, 9, 11,  6, 8};
    constexpr int NB[60] = {13, 12, 15, 14, 8, 6, 11, 10,  5, 7, 9, 4, 13, 14, 15, 12,  1, 3, 5, 8, 9, 11, 13, 15,  2, 3, 10, 11, 7, 9, 14, 15,  2, 12, 6, 7, 10, 11, 14,  4, 6, 8, 10, 13, 14,  4, 6, 12, 13,  5, 8, 9, 12,  4, 6, 8, 10, 12,  7, 9};
#pragma unroll
    for (int i = 0; i < 60; ++i) { const float hi = fmaxf(v[NA[i]], v[NB[i]]), lo = fminf(v[NA[i]], v[NB[i]]); v[NA[i]] = hi; v[NB[i]] = lo; }
}
__device__ __forceinline__ void merge16_desc(float (&x)[16], const float (&y)[16]) {
#pragma unroll
    for (int i = 0; i < 16; ++i) x[i] = fmaxf(x[i], y[15 - i]);
#pragma unroll
    for (int j = 8; j > 0; j >>= 1)
#pragma unroll
        for (int i = 0; i < 16; ++i) {
            const int l = i ^ j;
            if (l > i) { const float hi = fmaxf(x[i], x[l]), lo = fminf(x[i], x[l]); x[i] = hi; x[l] = lo; }
        }
}
__device__ __forceinline__ void xlane_merge16(float (&x)[16]) {
    float y[16];
#pragma unroll
    for (int i = 0; i < 16; ++i) y[i] = __shfl_xor(x[i], 16, 64);
    merge16_desc(x, y);
#pragma unroll
    for (int i = 0; i < 16; ++i) y[i] = __shfl_xor(x[i], 32, 64);
    merge16_desc(x, y);
}
__device__ __forceinline__ float pk(float v, unsigned payload, unsigned mask) { return __uint_as_float((__float_as_uint(v) & ~mask) | payload); }

__device__ __forceinline__ void phase_topk(const Params& p, unsigned char* lds) {
    const int tid = otid(), lane = tid & 63, wave = tid >> 6;
    const int c = lane & 15, q = lane >> 4;
    int* KT = (int*)lds + wave * (16 * 32);
    bf16_t* KL = (bf16_t*)(lds + 16384);
    const bf16_t* Q = (const bf16_t*)(p.ws + OFF_PROJ);
    const bf16_t* KP = (const bf16_t*)(p.ws + OFF_KEYS);
    int* EIDX = (int*)(p.ws + OFF_EIDX); float* GATE = (float*)(p.ws + OFF_GATE);
    const int h = wave;
    constexpr int CA[48] = {1, 1, 1, 1, 1, 1, 1, 1, 2, 2, 2, 2, 2, 3, 3, 3, 3, 4, 4, 4, 5, 5, 6, 6, 7, 7, 8, 9, 10, 11, 12, 13, 14, 15, -1, -1, -1, -1, -1, -1, -1, -1, -1, -1, -1, -1, -1, -1};
    constexpr int CB[48] = {0, 1, 2, 3, 4, 5, 6, 7, 0, 1, 2, 3, 4, 0, 1, 2, 3, 0, 1, 2, 0, 1, 0, 1, 0, 1, 0, 0, 0, 0, 0, 0, 0, 0, -1, -1, -1, -1, -1, -1, -1, -1, -1, -1, -1, -1, -1, -1};
    {
        const uint4* ks = (const uint4*)KP; uint4* kd = (uint4*)KL;
#pragma unroll
        for (int i = 0; i < 8; ++i) kd[tid + NT * i] = ks[tid + NT * i];
        __syncthreads();
    }
    bf16x8 cq[8];
    {
        const int tg0 = (int)blockIdx.x < NTOK / 16 ? (int)blockIdx.x : 0;
#pragma unroll
        for (int i = 0; i < 8; ++i) cq[i] = *(const bf16x8*)(Q + (size_t)(tg0 * 16 + c) * 2048 + h * 256 + i * 32 + q * 8);
    }
    for (int tg = blockIdx.x; tg < NTOK / 16; tg += gridDim.x) {
        const int tok0 = tg * 16;
        const int tgn = (tg + (int)gridDim.x < NTOK / 16) ? tg + (int)gridDim.x : tg;
        unsigned koff = 16384u; asm volatile("" : "+v"(koff));
        const LAS bf16_t* KPi = (const LAS bf16_t*)((LAS unsigned char*)lds + koff);
        float top[2][16];
#pragma unroll
        for (int half = 0; half < 2; ++half) {
            f32x4 acc[8];
#pragma unroll
            for (int m = 0; m < 8; ++m) acc[m] = (f32x4){0.f, 0.f, 0.f, 0.f};
#pragma unroll
            for (int kt = 0; kt < 4; ++kt) {
                const bf16x8 bq = cq[half * 4 + kt];
#pragma unroll
                for (int m = 0; m < 8; ++m) {
                    const bf16x8 ak = *(const LAS bf16x8*)(KPi + half * 16384 + ((m * 4 + kt) * 64 + lane) * 8);
                    acc[m] = __builtin_amdgcn_mfma_f32_16x16x32_bf16(ak, bq, acc[m], 0, 0, 0);
                }
                __builtin_amdgcn_sched_barrier(0);
            }
#pragma unroll
            for (int kt = 0; kt < 4; ++kt) cq[half * 4 + kt] = *(const bf16x8*)(Q + (size_t)(tgn * 16 + c) * 2048 + h * 256 + (half * 4 + kt) * 32 + q * 8);
            float lo16[16], hi16[16];
#pragma unroll
            for (int m = 0; m < 4; ++m)
#pragma unroll
                for (int r = 0; r < 4; ++r) {
                    lo16[m * 4 + r] = pk(acc[m][r], (unsigned)(m * 16 + 4 * q + r), 127u);
                    hi16[m * 4 + r] = pk(acc[m + 4][r], (unsigned)((m + 4) * 16 + 4 * q + r), 127u);
                }
            sort16_desc(lo16);
            sort16_desc(hi16);
            merge16_desc(lo16, hi16);
            xlane_merge16(lo16);
#pragma unroll
            for (int i = 0; i < 16; ++i) top[half][i] = lo16[i];
        }
        if (q == 0) {
#pragma unroll
            for (int i = 0; i < 16; i += 4) {
                *(int4*)(KT + c * 32 + i) = make_int4(__float_as_int(top[0][i]) & 127, __float_as_int(top[0][i + 1]) & 127, __float_as_int(top[0][i + 2]) & 127, __float_as_int(top[0][i + 3]) & 127);
                *(int4*)(KT + c * 32 + 16 + i) = make_int4(__float_as_int(top[1][i]) & 127, __float_as_int(top[1][i + 1]) & 127, __float_as_int(top[1][i + 2]) & 127, __float_as_int(top[1][i + 3]) & 127);
            }
        }
        float g0[16], g1[16], g2[16], g3[16];
#pragma unroll
        for (int b2 = 0; b2 < 16; ++b2) g0[b2] = pk(top[0][0] + top[1][b2], (unsigned)b2, 255u);
#pragma unroll
        for (int n = 0; n < 16; ++n) {
            g1[n] = (CA[n] >= 0) ? pk(top[0][CA[n] < 0 ? 0 : CA[n]] + top[1][CB[n] < 0 ? 0 : CB[n]], (unsigned)(CA[n] * 16 + CB[n]), 255u) : -INFINITY;
            g2[n] = (CA[16 + n] >= 0) ? pk(top[0][CA[16 + n] < 0 ? 0 : CA[16 + n]] + top[1][CB[16 + n] < 0 ? 0 : CB[16 + n]], (unsigned)(CA[16 + n] * 16 + CB[16 + n]), 255u) : -INFINITY;
            g3[n] = (CA[32 + n] >= 0) ? pk(top[0][CA[32 + n] < 0 ? 0 : CA[32 + n]] + top[1][CB[32 + n] < 0 ? 0 : CB[32 + n]], (unsigned)(CA[32 + n] * 16 + CB[32 + n]), 255u) : -INFINITY;
        }
        sort16_desc(g0); sort16_desc(g1); sort16_desc(g2); sort16_desc(g3);
        merge16_desc(g0, g1); merge16_desc(g2, g3); merge16_desc(g0, g2);
        float sum = 0.f, ex[16];
        const float mx = __uint_as_float(__float_as_uint(g0[0]) & ~255u);
#pragma unroll
        for (int r = 0; r < 16; ++r) { ex[r] = fexp(__uint_as_float(__float_as_uint(g0[r]) & ~255u) - mx); sum += ex[r]; }
        const float inv = 1.0f / sum;
        __syncthreads();
        int eo[4]; float go[4];
#pragma unroll
        for (int i = 0; i < 4; ++i) {
            const float xv = (q == 0) ? g0[i] : (q == 1) ? g0[4 + i] : (q == 2) ? g0[8 + i] : g0[12 + i];
            const float xe = (q == 0) ? ex[i] : (q == 1) ? ex[4 + i] : (q == 2) ? ex[8 + i] : ex[12 + i];
            const unsigned pl = __float_as_uint(xv) & 255u;
            eo[i] = KT[c * 32 + (pl >> 4)] * 128 + KT[c * 32 + 16 + (pl & 15u)];
            go[i] = xe * inv;
        }
        const size_t o = ((size_t)(tok0 + c) * 8 + h) * 16 + 4 * q;
        *(int4*)(EIDX + o) = make_int4(eo[0], eo[1], eo[2], eo[3]);
        *(float4*)(GATE + o) = make_float4(go[0], go[1], go[2], go[3]);
        __syncthreads();
    }
}

typedef float f32x2_t __attribute__((ext_vector_type(2)));
constexpr int CW_XRANK = 4096;
__device__ __forceinline__ void peer_role(const Params& p, int my_xcc, int my_rank, int& slice, int& rank) {
    const unsigned* ctl = (const unsigned*)(p.ws + OFF_CTL);
    bool even = (gridDim.x % 8u) == 0u;
#pragma unroll
    for (int x = 0; x < 8; ++x) even = even && (__hip_atomic_load(ctl + CW_XRANK + 64 * x, __ATOMIC_RELAXED, __HIP_MEMORY_SCOPE_AGENT) == gridDim.x / 8u);
    if (even) { slice = my_xcc; rank = my_rank; } else { slice = (int)(blockIdx.x & 7u); rank = (int)(blockIdx.x >> 3); }
}
#define ASM_LD16(dst, off, base) asm volatile("s_nop 4\n\tglobal_load_dwordx4 %0, %1, %2" : "+v"(dst) : "v"(off), "s"(base))
#define ASM_LD8(dst, off, base)  asm volatile("s_nop 4\n\tglobal_load_dwordx2 %0, %1, %2" : "+v"(dst) : "v"(off), "s"(base))
#define ASM_LD4(dst, off, base)  asm volatile("s_nop 4\n\tglobal_load_dword %0, %1, %2" : "+v"(dst) : "v"(off), "s"(base))
#define ASM_WAIT1(n, a)          asm volatile("s_waitcnt vmcnt(" #n ")" : "+v"(a))
#define ASM_WAIT2(n, a, b)       asm volatile("s_waitcnt vmcnt(" #n ")" : "+v"(a), "+v"(b))
#define PU_STEP(eC, hC, eN, hN, TOK)                                                                                                                    \
    {                                                                                                                                                   \
        const int tk = (TOK);                                                                                                                           \
        ASM_WAIT2(16, hC, eC);                                                                \
        {                                                                                                                                               \
            const int tn = (tk + tstep < NTOK) ? tk + tstep : tk, t2 = (tk + 2 * tstep < NTOK) ? tk + 2 * tstep : tk;                                  \
            ASM_LD4(hN, (unsigned)(tn * D + slice * 128 + 2 * lane) * 2u, H2b);                                                                         \
            ASM_LD8(eN, (unsigned)(t2 * 128 + 2 * lane) * 4u, Eb);                                                                                      \
        }                                                                                                                                               \
        f32x2_t hf2[8];                                                       \
        _Pragma("unroll") for (int i = 0; i < 8; ++i) { const unsigned hw = (unsigned)__shfl((int)hC, c8 * 8 + i, 64); hf2[i].x = bflo(hw); hf2[i].y = bfhi(hw); } \
        float d[16];                                                                                                                                    \
        _Pragma("unroll") for (int k = 0; k < 8; ++k) {                                                                                                 \
            const unsigned ea = (unsigned)__shfl((int)eC[0], ps * 8 + k, 64), eb = (unsigned)__shfl((int)eC[1], ps * 8 + k, 64);                        \
            _Pragma("unroll") for (int hf = 0; hf < 2; ++hf) {                                                                                          \
                const int it = 2 * k + hf;                                                                                                              \
                ASM_WAIT1(17, q[it]);                \
                f32x2_t uf[8];                                                                                                                          \
                _Pragma("unroll") for (int i = 0; i < 4; ++i) { uf[2 * i] = __builtin_amdgcn_cvt_pk_f32_fp8((int)q[it][i], false); uf[2 * i + 1] = __builtin_amdgcn_cvt_pk_f32_fp8((int)q[it][i], true); } \
                asm volatile("" : "+v"(uf[0]), "+v"(uf[1]), "+v"(uf[2]), "+v"(uf[3]), "+v"(uf[4]), "+v"(uf[5]), "+v"(uf[6]), "+v"(uf[7]));     \
                ASM_LD16(q[it], (hf ? eb : ea) * 128u + lo, Us);                          \
                f32x2_t s2 = {0.f, 0.f};                                                                                                                \
                _Pragma("unroll") for (int i = 0; i < 8; ++i) s2 = __builtin_elementwise_fma(uf[i], hf2[i], s2);                                        \
                d[it] = s2.x + s2.y;                                                                                                                    \
            }                                                                                                                                           \
        }                                                                                                                                               \
        float r8[8], r4[4], r2[2];                                                                                                                      \
        _Pragma("unroll") for (int i = 0; i < 8; ++i) { const float keep = b2 ? d[i + 8] : d[i], send = b2 ? d[i] : d[i + 8]; r8[i] = keep + __shfl_xor(send, 4, 64); } \
        _Pragma("unroll") for (int i = 0; i < 4; ++i) { const float keep = b1 ? r8[i + 4] : r8[i], send = b1 ? r8[i] : r8[i + 4]; r4[i] = keep + __shfl_xor(send, 2, 64); } \
        _Pragma("unroll") for (int i = 0; i < 2; ++i) { const float keep = b0 ? r4[i + 2] : r4[i], send = b0 ? r4[i] : r4[i + 2]; r2[i] = keep + __shfl_xor(send, 1, 64); } \
        if (tk < NTOK) *(unsigned*)(PD + (unsigned)(tk * 128 + ps * 16 + 2 * c8)) = pack2(r2[0], r2[1]);                                                \
    }
__device__ __forceinline__ void phase_pu(const Params& p, int slice_, int rank_) {
    const int slice = __builtin_amdgcn_readfirstlane(slice_), rank = __builtin_amdgcn_readfirstlane(rank_);
    const int tid = otid(), lane = tid & 63, wave = __builtin_amdgcn_readfirstlane(tid >> 6), c8 = lane & 7, ps = lane >> 3;
    const int nrank = (int)(gridDim.x >> 3);
    const unsigned char* H2b = p.ws + OFF_H;
    const unsigned char* Us = p.ws + OFF_UT8 + (size_t)slice * 16384 * 128;
    const unsigned char* Eb = p.ws + OFF_EIDX;
    const unsigned lo = 16u * (unsigned)c8;
    bf16_t* PD = (bf16_t*)(p.ws + OFF_PROJ) + (size_t)slice * NTOK * 128;
    const bool b0 = (lane & 1) != 0, b1 = (lane & 2) != 0, b2 = (lane & 4) != 0;
    const int tstep = nrank * NWAVE;
    int tok = rank * NWAVE + wave;
    u32x4_t q[16]; u32x2_t eA = {0u, 0u}, eB = {0u, 0u}; unsigned hA = 0u, hB = 0u;
#pragma unroll
    for (int i = 0; i < 16; ++i) q[i] = (u32x4_t){0u, 0u, 0u, 0u};
    {
        const int t0 = tok < NTOK ? tok : 0, t1 = tok + tstep < NTOK ? tok + tstep : t0;
        const u32x2_t e0 = *(const u32x2_t*)(Eb + (size_t)(unsigned)(t0 * 128 + 2 * lane) * 4);
#pragma unroll
        for (int k = 0; k < 8; ++k) {
            const unsigned ea = (unsigned)__shfl((int)e0[0], ps * 8 + k, 64), eb = (unsigned)__shfl((int)e0[1], ps * 8 + k, 64);
            if (k == 0) { ASM_LD4(hA, (unsigned)(t0 * D + slice * 128 + 2 * lane) * 2u, H2b); ASM_LD8(eA, (unsigned)(t1 * 128 + 2 * lane) * 4u, Eb); }
            ASM_LD16(q[2 * k], ea * 128u + lo, Us);
            ASM_LD16(q[2 * k + 1], eb * 128u + lo, Us);
        }
    }
    for (; tok < NTOK; tok += 2 * tstep) {
        PU_STEP(eA, hA, eB, hB, tok)
        PU_STEP(eB, hB, eA, hA, tok + tstep)
    }
    asm volatile("s_waitcnt vmcnt(0)" ::: "memory");
}
#undef PU_STEP
__device__ __forceinline__ void phase_pw(const Params& p) {
    const int gtid = blockIdx.x * NT + otid(), GT = gridDim.x * NT;
    const unsigned* PD2 = (const unsigned*)(p.ws + OFF_PROJ);
    const int2* EIDX2 = (const int2*)(p.ws + OFF_EIDX); const float2* GATE2 = (const float2*)(p.ws + OFF_GATE);
    const float* ISU = (const float*)(p.ws + OFF_ISU); const float* ISV = (const float*)(p.ws + OFF_ISV);
    float2* WG2 = (float2*)(p.ws + OFF_WG);
    for (int i2 = gtid; i2 < NTOK * 64; i2 += GT) {
        float s0 = 0.f, s1 = 0.f;
#pragma unroll
        for (int sl = 0; sl < 8; ++sl) { const unsigned v = PD2[(size_t)sl * NTOK * 64 + i2]; s0 += bflo(v); s1 += bfhi(v); }
        const int2 e = EIDX2[i2]; const float2 g = GATE2[i2];
        WG2[i2] = make_float2(g.x * geluf_(s0 * ISU[e.x]) * ISV[e.x], g.y * geluf_(s1 * ISU[e.y]) * ISV[e.y]);
    }
}
#define ASM_WAIT4(n, a, b, c, d) asm volatile("s_waitcnt vmcnt(" #n ")" : "+v"(a), "+v"(b), "+v"(c), "+v"(d))
#define PV_STEP(eC, wC, xC, mC, eN, wN, xN, mN, TOK)                                                                                                    \
    {                                                                                                                                                   \
        const int tk = (TOK);                                                                                                                           \
        ASM_WAIT4(16, eC, wC, xC, mC);                                                        \
        {                                                                                                                                               \
            const int tn = (tk + tstep < NTOK) ? tk + tstep : tk, t2 = (tk + 2 * tstep < NTOK) ? tk + 2 * tstep : tk;                                  \
            ASM_LD8(wN, (unsigned)(tn * 128 + 2 * lane) * 4u, Wb);                                                                                      \
            ASM_LD8(xN, (unsigned)(tn * D + ch) * 4u, Xb);                                                                                              \
            ASM_LD4(mN, (unsigned)(tn * D + ch) * 2u, Mb);                                                                                              \
            ASM_LD8(eN, (unsigned)(t2 * 128 + 2 * lane) * 4u, Eb);                                                                                      \
        }                                                                                                                                               \
        f32x2_t acc2[8];                                                                                                                                \
        _Pragma("unroll") for (int i = 0; i < 8; ++i) acc2[i] = (f32x2_t){0.f, 0.f};                                                                    \
        _Pragma("unroll") for (int k = 0; k < 8; ++k) {                                                                                                 \
            const unsigned ea = (unsigned)__shfl((int)eC[0], ps * 8 + k, 64), eb = (unsigned)__shfl((int)eC[1], ps * 8 + k, 64);                        \
            const float wa = __uint_as_float((unsigned)__shfl((int)wC[0], ps * 8 + k, 64)), wb = __uint_as_float((unsigned)__shfl((int)wC[1], ps * 8 + k, 64)); \
            _Pragma("unroll") for (int hf = 0; hf < 2; ++hf) {                                                                                          \
                const int it = 2 * k + hf;                                                                                                              \
                ASM_WAIT1(19, q[it]);               \
                f32x2_t vf[8];                                                                                                                          \
                _Pragma("unroll") for (int i = 0; i < 4; ++i) { vf[2 * i] = __builtin_amdgcn_cvt_pk_f32_fp8((int)q[it][i], false); vf[2 * i + 1] = __builtin_amdgcn_cvt_pk_f32_fp8((int)q[it][i], true); } \
                asm volatile("" : "+v"(vf[0]), "+v"(vf[1]), "+v"(vf[2]), "+v"(vf[3]), "+v"(vf[4]), "+v"(vf[5]), "+v"(vf[6]), "+v"(vf[7]));     \
                ASM_LD16(q[it], (hf ? eb : ea) * 128u + lo, Vs);                          \
                const float wsc = hf ? wb : wa;                                                                                                         \
                const f32x2_t ww = {wsc, wsc};                                                                                                          \
                _Pragma("unroll") for (int i = 0; i < 8; ++i) acc2[i] = __builtin_elementwise_fma(vf[i], ww, acc2[i]);                                  \
            }                                                                                                                                           \
        }                                                                                                                                               \
        float acc[16];                                                                                                                                  \
        _Pragma("unroll") for (int i = 0; i < 8; ++i) { acc[2 * i] = acc2[i].x; acc[2 * i + 1] = acc2[i].y; }                                           \
        float r8[8], r4[4], r2[2];                                                                                                                      \
        _Pragma("unroll") for (int i = 0; i < 8; ++i) { const float keep = b5 ? acc[i + 8] : acc[i], send = b5 ? acc[i] : acc[i + 8]; r8[i] = keep + __shfl_xor(send, 32, 64); } \
        _Pragma("unroll") for (int i = 0; i < 4; ++i) { const float keep = b4 ? r8[i + 4] : r8[i], send = b4 ? r8[i] : r8[i + 4]; r4[i] = keep + __shfl_xor(send, 16, 64); } \
        _Pragma("unroll") for (int i = 0; i < 2; ++i) { const float keep = b3 ? r4[i + 2] : r4[i], send = b3 ? r4[i] : r4[i + 2]; r2[i] = keep + __shfl_xor(send, 8, 64); } \
        const bool hbt = (tk >> 14) != 0;                                                                                                               \
        const float2 gv = hbt ? gv1 : gv0, g1 = hbt ? g11 : g10;                                                                                        \
        if (tk < NTOK) *(float2*)(out + (unsigned)(tk * D + ch)) = make_float2(__uint_as_float(xC[0]) + g1.x * bflo(mC) + gv.x * r2[0], __uint_as_float(xC[1]) + g1.y * bfhi(mC) + gv.y * r2[1]); \
    }
__device__ __forceinline__ void phase_pv(const Params& p, int slice_, int rank_) {
    const int slice = __builtin_amdgcn_readfirstlane(slice_), rank = __builtin_amdgcn_readfirstlane(rank_);
    const int tid = otid(), lane = tid & 63, wave = __builtin_amdgcn_readfirstlane(tid >> 6), c8 = lane & 7, ps = lane >> 3;
    const int nrank = (int)(gridDim.x >> 3);
    const unsigned char* Vs = p.ws + OFF_VT8 + (size_t)slice * 16384 * 128;
    const unsigned char* Eb = p.ws + OFF_EIDX; const unsigned char* Wb = p.ws + OFF_WG;
    const unsigned char* Xb = (const unsigned char*)p.in[0]; const unsigned char* Mb = p.ws + OFF_MIX;
    const unsigned lo = 16u * (unsigned)c8;
    const float* mod = (const float*)(p.ws + OFF_MOD);
    float* out = p.out;
    const bool b3 = (lane & 8) != 0, b4 = (lane & 16) != 0, b5 = (lane & 32) != 0;
    const int tstep = nrank * NWAVE;
    const int ch = slice * 128 + c8 * 16 + 2 * ps;
    const float2 gv0 = *(const float2*)(mod + 5120 + ch), gv1 = *(const float2*)(mod + 6144 + 5120 + ch);
    const float2 g10 = *(const float2*)(mod + 2048 + ch), g11 = *(const float2*)(mod + 6144 + 2048 + ch);
    int tok = rank * NWAVE + wave;
    u32x4_t q[16];
    u32x2_t eA = {0u, 0u}, eB = {0u, 0u}, wA = {0u, 0u}, wB = {0u, 0u}, xA = {0u, 0u}, xB = {0u, 0u}; unsigned mA = 0u, mB = 0u;
#pragma unroll
    for (int i = 0; i < 16; ++i) q[i] = (u32x4_t){0u, 0u, 0u, 0u};
    {
        const int t0 = tok < NTOK ? tok : 0, t1 = tok + tstep < NTOK ? tok + tstep : t0;
        const u32x2_t e0 = *(const u32x2_t*)(Eb + (size_t)(unsigned)(t0 * 128 + 2 * lane) * 4);
#pragma unroll
        for (int k = 0; k < 8; ++k) {
            const unsigned ea = (unsigned)__shfl((int)e0[0], ps * 8 + k, 64), eb = (unsigned)__shfl((int)e0[1], ps * 8 + k, 64);
            if (k == 0) {
                ASM_LD8(wA, (unsigned)(t0 * 128 + 2 * lane) * 4u, Wb); ASM_LD8(xA, (unsigned)(t0 * D + ch) * 4u, Xb);
                ASM_LD4(mA, (unsigned)(t0 * D + ch) * 2u, Mb); ASM_LD8(eA, (unsigned)(t1 * 128 + 2 * lane) * 4u, Eb);
            }
            ASM_LD16(q[2 * k], ea * 128u + lo, Vs);
            ASM_LD16(q[2 * k + 1], eb * 128u + lo, Vs);
        }
    }
    for (; tok < NTOK; tok += 2 * tstep) {
        PV_STEP(eA, wA, xA, mA, eB, wB, xB, mB, tok)
        PV_STEP(eB, wB, xB, mB, eA, wA, xA, mA, tok + tstep)
    }
    asm volatile("s_waitcnt vmcnt(0)" ::: "memory");
}
#undef PV_STEP
__device__ __forceinline__ void phase_pn(const Params& p) {
    const int tid = otid(), lane = tid & 63, wave = tid >> 6;
    const int gw = blockIdx.x * NWAVE + wave, GW = gridDim.x * NWAVE;
    const float* fnw = p.in[25];
    float4 fw[4];
#pragma unroll
    for (int j = 0; j < 4; ++j) fw[j] = ((const float4*)fnw)[j * 64 + lane];
    for (int row = gw; row < NTOK; row += GW) {
        float4* xr = (float4*)(p.out + (size_t)row * D);
        float4 v[4]; float ss = 0.f;
#pragma unroll
        for (int j = 0; j < 4; ++j) { v[j] = xr[j * 64 + lane]; ss += v[j].x * v[j].x + v[j].y * v[j].y + v[j].z * v[j].z + v[j].w * v[j].w; }
        ss = wave_sum(ss);
        const float rstd = rsqrtf(ss * (1.0f / D) + EPS);
#pragma unroll
        for (int j = 0; j < 4; ++j) xr[j * 64 + lane] = make_float4(v[j].x * rstd * fw[j].x, v[j].y * rstd * fw[j].y, v[j].z * rstd * fw[j].z, v[j].w * rstd * fw[j].w);
    }
}

#define XB_TMO      128
#define XB_XCNT(j)  (256  + 64 * (j))
#define XB_XSUB(j)  (1280 + 64 * (j))
#define XB_XGEN(j)  (2304 + 64 * (j))
#define XB_TOP      3328
#define XB_TOPGEN   3392
#define XCD_BAR_WORDS 3456
#define XB_SPIN_CAP (1u << 18)

__device__ __forceinline__ unsigned xb_ld(unsigned* p)              { return __hip_atomic_load(p, __ATOMIC_RELAXED, __HIP_MEMORY_SCOPE_AGENT); }
__device__ __forceinline__ unsigned xb_add(unsigned* p, unsigned v) { return __hip_atomic_fetch_add(p, v, __ATOMIC_RELAXED, __HIP_MEMORY_SCOPE_AGENT); }
__device__ __forceinline__ unsigned xb_xcc_id() { return (unsigned)__builtin_amdgcn_s_getreg((3 << 11) | 20) & 0xFu; }
#define XB_SPIN(cond, bar) do { unsigned _sp = 0; while (cond) { __builtin_amdgcn_s_sleep(1); \
    if ((++_sp & 255u) == 0u) { if (xb_ld(&(bar)[XB_TMO])) break; if (_sp > XB_SPIN_CAP) { atomicAdd(&(bar)[XB_TMO], 1u); break; } } } } while (0)

struct XcdBarrier {
    unsigned* bar; unsigned x;
    volatile LAS unsigned* st;
};

__device__ __forceinline__ XcdBarrier xcd_barrier_post(unsigned* bar, volatile LAS unsigned* st) {
    XcdBarrier b; b.bar = bar; b.x = xb_xcc_id(); b.st = st;
    if (threadIdx.x == 0) (void)xb_add(&bar[XB_XCNT(b.x)], 1u);
    return b;
}
__device__ __forceinline__ void xcd_barrier_complete(unsigned* bar, unsigned x, unsigned& nloc, unsigned& nx) {
    const unsigned G = gridDim.x * gridDim.y * gridDim.z;
    unsigned sum, cnt, mine, sp = 0u;
    for (;;) {
        sum = 0u; cnt = 0u; mine = 0u;
#pragma unroll
        for (unsigned j = 0; j < 16; ++j) { const unsigned c = xb_ld(&bar[XB_XCNT(j)]); sum += c; cnt += (c > 0u) ? 1u : 0u; mine = (j == x) ? c : mine; }
        if (sum == G) break;
        __builtin_amdgcn_s_sleep(1);
        if ((++sp & 255u) == 0u) { if (xb_ld(&bar[XB_TMO])) break; if (sp > XB_SPIN_CAP) { atomicAdd(&bar[XB_TMO], 1u); break; } }
    }
    nloc = mine > 0u ? mine : 1u; nx = cnt > 0u ? cnt : 1u;
}

__device__ __forceinline__ void xcd_barrier(const XcdBarrier& b) {
    asm volatile("s_waitcnt vmcnt(0)" ::: "memory");
    __syncthreads();
    if (threadIdx.x == 0) {
        unsigned* bar = b.bar;
        __builtin_amdgcn_s_waitcnt(0);
        unsigned nloc = b.st[0], nx = b.st[1];
        if (nloc == 0u) { xcd_barrier_complete(bar, b.x, nloc, nx); b.st[0] = nloc; b.st[1] = nx; }
        const unsigned old = xb_add(&bar[XB_XSUB(b.x)], 1u);
        const unsigned gen = old / nloc;
        if (old + 1u == (gen + 1u) * nloc) {
            __builtin_amdgcn_fence(__ATOMIC_RELEASE, "agent");
            asm volatile("s_waitcnt vmcnt(0)" ::: "memory");
            const unsigned og = xb_add(&bar[XB_TOP], 1u);
            const unsigned tg = og / nx;
            if (og + 1u == (tg + 1u) * nx) xb_add(&bar[XB_TOPGEN], 1u);
            else XB_SPIN(xb_ld(&bar[XB_TOPGEN]) == tg, bar);
            __builtin_amdgcn_fence(__ATOMIC_ACQUIRE, "agent");
            xb_add(&bar[XB_XGEN(b.x)], 1u);
            asm volatile("s_waitcnt vmcnt(0)" ::: "memory");
        } else {
            XB_SPIN(xb_ld(&bar[XB_XGEN(b.x)]) == gen, bar);
            __builtin_amdgcn_fence(__ATOMIC_ACQUIRE, "agent");
            asm volatile("s_waitcnt vmcnt(0)" ::: "memory");
        }
    }
    __syncthreads();
}

constexpr int N_PHASES = 15;
template <int PH>
__device__ __forceinline__ void run_phase(const Params& p, unsigned char* lds, int xcc, int xrank) {
    unsigned char* ws = p.ws;
    if (PH == 0) phase_prep(p, lds);
    if (PH == 1) phase_norm<false>(p, p.in[0], nullptr, p.in[4], 0, 1024, (bf16_t*)(ws + OFF_H));
    if (PH == 2) gemm_run(lds, (const bf16_t*)(ws + OFF_H), (const bf16_t*)(ws + OFF_WIN), NTOK, INW, D, pg8::EpiBf16<0>{(bf16_t*)(ws + OFF_PROJ), INW, nullptr, 0, 0});
    if (PH == 3) { phase_hg1(p, lds); phase_s5_scan<false>(p, lds); }
    if (PH == 4) { phase_hg2(p); phase_s5_carry(p); }
    if (PH == 5) { phase_hg3(p, lds); phase_s5_scan<true>(p, lds); }
    if (PH == 6) gemm_run(lds, (const bf16_t*)(ws + OFF_YG), (const bf16_t*)(ws + OFF_WGLU), NTOK, 512, 512, EpiGlu{(const bf16_t*)(ws + OFF_YG), p.in[19], (bf16_t*)(ws + OFF_OCAT)});
    if (PH == 7) gemm_run(lds, (const bf16_t*)(ws + OFF_OCAT), (const bf16_t*)(ws + OFF_WOUT), NTOK, D, D, pg8::EpiBf16<0>{(bf16_t*)(ws + OFF_MIX), D, nullptr, 0, 0});
    if (PH == 8) phase_norm<true>(p, p.in[0], (const bf16_t*)(ws + OFF_MIX), p.in[5], 3072, 4096, (bf16_t*)(ws + OFF_H));
    if (PH == 9) gemm_run(lds, (const bf16_t*)(ws + OFF_H), (const bf16_t*)(ws + OFF_WQ), NTOK, 2048, D, pg8::EpiBf16<0>{(bf16_t*)(ws + OFF_PROJ), 2048, nullptr, 0, 0});
    if (PH == 10) phase_topk(p, lds);
    if (PH == 11) { int sl, rk; peer_role(p, xcc, xrank, sl, rk); phase_pu(p, sl, rk); }
    if (PH == 12) phase_pw(p);
    if (PH == 13) { int sl, rk; peer_role(p, xcc, xrank, sl, rk); phase_pv(p, sl, rk); }
    if (PH == 14) phase_pn(p);
}

template <int PH>
__global__ void __launch_bounds__(NT, 2) k_phase(Params p) {
    __shared__ __attribute__((aligned(16))) unsigned char lds[LDS_BYTES];
    run_phase<PH>(p, lds, 99, 0);
}

#if ONE_LAUNCH
#ifndef REP_MASK
#define REP_MASK 0
#endif
template <int PH>
__device__ __forceinline__ void run_rep(const Params& p, unsigned char* lds, cg::grid_group& grid, const XcdBarrier& bar, int xcc, int xrank) {
    run_phase<PH>(p, lds, xcc, xrank);
    if (PH == 0) grid.sync();
    else if (PH != N_PHASES - 1) xcd_barrier(bar);
    if ((REP_MASK >> PH) & 1) { run_phase<PH>(p, lds, xcc, xrank); xcd_barrier(bar); }
}
__global__ void __launch_bounds__(NT, 2) k_mega(Params p) {
    __shared__ __attribute__((aligned(16))) unsigned char lds[LDS_BYTES];
    cg::grid_group grid = cg::this_grid();
    volatile LAS unsigned* st = (volatile LAS unsigned*)(LAS unsigned char*)(lds + LDS_PHASE_BYTES);
    if (threadIdx.x < 4) st[threadIdx.x] = 0u;
    __syncthreads();
    const XcdBarrier bar = xcd_barrier_post((unsigned*)(p.ws + OFF_CTL), st);
    const int xcc = __builtin_amdgcn_readfirstlane((int)bar.x);
    if (threadIdx.x == 0) st[2] = (xcc < 8) ? xb_add((unsigned*)(p.ws + OFF_CTL) + CW_XRANK + 64 * xcc, 1u) : 0xffffu;
    __syncthreads();
    const int xrank = __builtin_amdgcn_readfirstlane((int)st[2]);
    run_rep<0>(p, lds, grid, bar, xcc, xrank); run_rep<1>(p, lds, grid, bar, xcc, xrank); run_rep<2>(p, lds, grid, bar, xcc, xrank); run_rep<3>(p, lds, grid, bar, xcc, xrank);
    run_rep<4>(p, lds, grid, bar, xcc, xrank); run_rep<5>(p, lds, grid, bar, xcc, xrank); run_rep<6>(p, lds, grid, bar, xcc, xrank); run_rep<7>(p, lds, grid, bar, xcc, xrank);
    run_rep<8>(p, lds, grid, bar, xcc, xrank); run_rep<9>(p, lds, grid, bar, xcc, xrank); run_rep<10>(p, lds, grid, bar, xcc, xrank); run_rep<11>(p, lds, grid, bar, xcc, xrank);
    run_rep<12>(p, lds, grid, bar, xcc, xrank); run_rep<13>(p, lds, grid, bar, xcc, xrank); run_rep<14>(p, lds, grid, bar, xcc, xrank);
}
#endif

template <int PH>
static void launch_phase(const Params& p, int grid, hipStream_t stream) {
    hipLaunchKernelGGL(k_phase<PH>, dim3(grid), dim3(NT), 0, stream, p);
}

extern "C" void kernel_launch(void* const* d_in, const int* in_sizes, int n_in, void* d_out, int out_size, void* d_ws, size_t ws_size, hipStream_t stream) {
    if (n_in != 26 || ws_size < WS_END) { fprintf(stderr, "kernel_launch: unexpected inputs (n_in %d, ws %zu)\n", n_in, ws_size); return; }
    Params p{};
    for (int i = 0; i < 26; ++i) p.in[i] = (const float*)d_in[i];
    p.out = (float*)d_out; p.ws = (unsigned char*)d_ws;
#if ONE_LAUNCH
    static int grid = 0;
    if (!grid) {
        int dev = 0, cus = 0, per_cu = 0;
        hipGetDevice(&dev);
        hipDeviceGetAttribute(&cus, hipDeviceAttributeMultiprocessorCount, dev);
        hipOccupancyMaxActiveBlocksPerMultiprocessor(&per_cu, k_mega, NT, 0);
        grid = (per_cu >= 1 ? cus : 0) & ~7;
        if (grid <= 0) { fprintf(stderr, "kernel_launch: no resident grid (cus %d, blocks per CU %d)\n", cus, per_cu); grid = -1; }
    }
    if (grid < 0) return;
    (void)hipMemsetAsync((unsigned char*)d_ws + OFF_CTL, 0, 32768, stream);
    void* args[] = {&p};
    hipError_t e = hipLaunchCooperativeKernel((void*)k_mega, dim3(grid), dim3(NT), args, 0, stream);
    if (e != hipSuccess) fprintf(stderr, "cooperative launch failed: %s (grid %d)\n", hipGetErrorString(e), grid);
#else
    const int grid = 256;
    launch_phase<0>(p, grid, stream); launch_phase<1>(p, grid, stream); launch_phase<2>(p, grid, stream);
    launch_phase<3>(p, grid, stream); launch_phase<4>(p, grid, stream); launch_phase<5>(p, grid, stream);
    launch_phase<6>(p, grid, stream); launch_phase<7>(p, grid, stream); launch_phase<8>(p, grid, stream);
    launch_phase<9>(p, grid, stream); launch_phase<10>(p, grid, stream); launch_phase<11>(p, grid, stream);
    launch_phase<12>(p, grid, stream); launch_phase<13>(p, grid, stream); launch_phase<14>(p, grid, stream);
#endif
}
```

```cpp
#include <hip/hip_runtime.h>
#include <hip/hip_cooperative_groups.h>
#include <stdint.h>
#include <stdio.h>
namespace cg = cooperative_groups;

#ifndef ONE_LAUNCH
#define ONE_LAUNCH 1
#endif

#define LAS __attribute__((address_space(3)))
typedef unsigned short bf16_t;
typedef __attribute__((ext_vector_type(8))) short bf16x8;
typedef __attribute__((ext_vector_type(4))) float f32x4;
typedef __attribute__((ext_vector_type(2))) __bf16 bf2_t;
typedef unsigned u32x4_t __attribute__((ext_vector_type(4)));
typedef unsigned u32x2_t __attribute__((ext_vector_type(2)));

constexpr int D = 1024, BATCH = 2, SEQ = 16384, NTOK = BATCH * SEQ;
constexpr int DK = 128;
constexpr int INW = 2560;
constexpr int NT = 512;
constexpr int NWAVE = NT / 64;
constexpr float EPS = 1e-6f;
constexpr int S5_SEG = 512, S5_NSEG = SEQ / S5_SEG;

constexpr size_t MiB = 1024ull * 1024ull;
constexpr size_t OFF_CTL   = 0;
constexpr size_t OFF_MOD   = 64 * 1024;
constexpr size_t OFF_LB    = OFF_MOD + 48 * 1024;
constexpr size_t OFF_S5AB  = OFF_LB + 2048;
constexpr size_t OFF_S5BB  = OFF_S5AB + 32 * 1024;
constexpr size_t OFF_MODP  = 512 * 1024;
constexpr size_t OFF_S5END = 1 * MiB;
constexpr size_t OFF_S5CAR = 2 * MiB;
constexpr size_t OFF_HGDEC = 3 * MiB;
constexpr size_t OFF_WIN   = 4 * MiB;
constexpr size_t OFF_WOUT  = 9 * MiB;
constexpr size_t OFF_WGLU  = 11 * MiB;
constexpr size_t OFF_KEYS  = 11 * MiB + 512 * 1024;
constexpr size_t OFF_WQ    = 12 * MiB;
constexpr size_t OFF_UT8   = 16 * MiB;
constexpr size_t OFF_VT8   = 32 * MiB;
constexpr size_t OFF_ISU   = 48 * MiB;
constexpr size_t OFF_ISV   = 48 * MiB + 65536;
constexpr size_t OFF_S5H16 = 49 * MiB;
constexpr size_t OFF_S5W16 = 52 * MiB;
constexpr size_t OFF_H     = 80 * MiB;
constexpr size_t OFF_PROJ  = 144 * MiB;
constexpr size_t OFF_OCAT  = 304 * MiB;
constexpr size_t OFF_HGS   = 368 * MiB;
constexpr size_t OFF_YG    = 432 * MiB;
constexpr size_t OFF_EIDX  = OFF_HGS;
constexpr size_t OFF_GATE  = OFF_HGS + 16 * MiB;
constexpr size_t OFF_WG    = OFF_GATE;
constexpr size_t OFF_MIX   = OFF_HGS + 32 * MiB;
constexpr size_t WS_END    = 464 * MiB;

constexpr int LDS_PHASE_BYTES = 139264;
constexpr int LDS_BYTES = LDS_PHASE_BYTES + 16;

struct Params {
    const float* in[26];
    float* out;
    unsigned char* ws;
};

__device__ __forceinline__ bf16_t f2bf(float f) { return __builtin_bit_cast(unsigned short, (__bf16)f); }
__device__ __forceinline__ float bf2f(bf16_t h) { return __uint_as_float(((unsigned)h) << 16); }
__device__ __forceinline__ unsigned pack2(float lo, float hi) { const bf2_t r = {(__bf16)lo, (__bf16)hi}; return __builtin_bit_cast(unsigned, r); }
__device__ __forceinline__ float bflo(unsigned u) { return __uint_as_float(u << 16); }
__device__ __forceinline__ float bfhi(unsigned u) { return __uint_as_float(u & 0xffff0000u); }
__device__ __forceinline__ float fexp(float x) { return __builtin_amdgcn_exp2f(x * 1.44269504088896341f); }
__device__ __forceinline__ float flog(float x) { return __builtin_amdgcn_logf(x) * 0.69314718055994531f; }
__device__ __forceinline__ float sigmoidf_(float x) { return __builtin_amdgcn_rcpf(1.0f + fexp(-x)); }
__device__ __forceinline__ float siluf_(float x) { return x * __builtin_amdgcn_rcpf(1.0f + fexp(-x)); }
__device__ __forceinline__ float geluf_(float v) {
    const float av = fabsf(v), t = __builtin_amdgcn_rcpf(av * 0.2316418882f + 1.0f);
    float q = t * 0.5307027145f + (-0.7265760135f); q = q * t + 0.7107068705f; q = q * t + (-0.142248368f); q = q * t + 0.127414796f; q = q * t;
    const float e = __builtin_amdgcn_exp2f((v * v) * (-0.72134752044f));
    const float m = v * (q * e);
    return v < 0.f ? m : v - m;
}
__device__ __forceinline__ int otid() { int t = threadIdx.x; asm volatile("" : "+v"(t)); return t; }
__device__ __forceinline__ float wave_sum(float v) {
#pragma unroll
    for (int m = 32; m >= 1; m >>= 1) v += __shfl_xor(v, m, 64);
    return v;
}

__device__ __forceinline__ void transpose_W(const float* __restrict__ W, bf16_t* __restrict__ Wt, int K, int N, int gtid, int GT) {
    const int ng = (K / 8) * N;
    for (int g = gtid; g < ng; g += GT) {
        const int n = g % N, k0 = (g / N) * 8;
        unsigned o[4];
#pragma unroll
        for (int j = 0; j < 4; ++j) o[j] = pack2(W[(size_t)(k0 + 2 * j) * N + n], W[(size_t)(k0 + 2 * j + 1) * N + n]);
        *(uint4*)(Wt + (size_t)n * K + k0) = make_uint4(o[0], o[1], o[2], o[3]);
    }
}
__device__ __forceinline__ void pack_BT(const float* __restrict__ Wt, bf16_t* __restrict__ Wp, int K, int N, int gtid, int GT) {
    const int KT = K / 32;
    const int ngrp = KT * (N / 16) * 64;
    for (int grp = gtid; grp < ngrp; grp += GT) {
        const int l = grp & 63, tile = grp >> 6;
        const int kt = tile % KT, nt = tile / KT;
        const int k0 = kt * 32 + 8 * (l >> 4), n = nt * 16 + (l & 15);
        const float* s = Wt + (size_t)n * K + k0;
        unsigned o[4];
#pragma unroll
        for (int j = 0; j < 4; ++j) o[j] = pack2(s[2 * j], s[2 * j + 1]);
        *(uint4*)(Wp + (size_t)grp * 8) = make_uint4(o[0], o[1], o[2], o[3]);
    }
}
__device__ __forceinline__ void cvt_table_fp8(const float* __restrict__ src, unsigned char* __restrict__ dst, float* __restrict__ inv, int gw, int GW, int lane) {
    for (int row = gw; row < 16384; row += GW) {
        const float4* s = (const float4*)(src + (size_t)row * 1024) + lane * 4;
        const float4 a0 = s[0], a1 = s[1], a2 = s[2], a3 = s[3];
        float m = fmaxf(fmaxf(fmaxf(fabsf(a0.x), fabsf(a0.y)), fmaxf(fabsf(a0.z), fabsf(a0.w))), fmaxf(fmaxf(fabsf(a1.x), fabsf(a1.y)), fmaxf(fabsf(a1.z), fabsf(a1.w))));
        m = fmaxf(m, fmaxf(fmaxf(fmaxf(fabsf(a2.x), fabsf(a2.y)), fmaxf(fabsf(a2.z), fabsf(a2.w))), fmaxf(fmaxf(fabsf(a3.x), fabsf(a3.y)), fmaxf(fabsf(a3.z), fabsf(a3.w)))));
#pragma unroll
        for (int o = 32; o >= 1; o >>= 1) m = fmaxf(m, __shfl_xor(m, o, 64));
        const float sc = (m > 0.f) ? exp2f(floorf(log2f(384.f / m))) : 1.f;
        int w0 = 0, w1 = 0, w2 = 0, w3 = 0;
        w0 = __builtin_amdgcn_cvt_pk_fp8_f32(a0.x * sc, a0.y * sc, w0, false); w0 = __builtin_amdgcn_cvt_pk_fp8_f32(a0.z * sc, a0.w * sc, w0, true);
        w1 = __builtin_amdgcn_cvt_pk_fp8_f32(a1.x * sc, a1.y * sc, w1, false); w1 = __builtin_amdgcn_cvt_pk_fp8_f32(a1.z * sc, a1.w * sc, w1, true);
        w2 = __builtin_amdgcn_cvt_pk_fp8_f32(a2.x * sc, a2.y * sc, w2, false); w2 = __builtin_amdgcn_cvt_pk_fp8_f32(a2.z * sc, a2.w * sc, w2, true);
        w3 = __builtin_amdgcn_cvt_pk_fp8_f32(a3.x * sc, a3.y * sc, w3, false); w3 = __builtin_amdgcn_cvt_pk_fp8_f32(a3.z * sc, a3.w * sc, w3, true);
        *(int4*)(dst + ((size_t)(lane >> 3) * 16384 + row) * 128 + (lane & 7) * 16) = make_int4(w0, w1, w2, w3);
        if (lane == 0) inv[row] = 1.0f / sc;
    }
}

__device__ __forceinline__ void phase_prep(const Params& p, unsigned char* lds) {
    const int tid = otid(), bid = blockIdx.x, nb = gridDim.x;
    const int lane = tid & 63, wave = tid >> 6;
    const int gtid = bid * NT + tid, GT = nb * NT;
    unsigned char* ws = p.ws;
    {
        const float* c = p.in[1]; const float* aw = p.in[2]; const float* ab = p.in[3];
        float* modp = (float*)(ws + OFF_MODP);
        float* red = (float*)lds;
        for (int item = bid; item < 384; item += nb) {
            const int cg = item % 96, kc = item / 96;
            const int col = cg * 64 + lane;
            float a0 = 0.f, a1 = 0.f;
            const int k0 = kc * 256 + wave * 32;
#pragma unroll 8
            for (int k = k0; k < k0 + 32; ++k) {
                const float w = aw[(size_t)k * 6144 + col];
                a0 += siluf_(c[k]) * w; a1 += siluf_(c[1024 + k]) * w;
            }
            red[(wave * 2 + 0) * 64 + lane] = a0; red[(wave * 2 + 1) * 64 + lane] = a1;
            __syncthreads();
            if (tid < 128) {
                const int b = tid >> 6, l = tid & 63;
                float s = (kc == 0) ? ab[cg * 64 + l] : 0.f;
                for (int w = 0; w < NWAVE; ++w) s += red[(w * 2 + b) * 64 + l];
                modp[(kc * 2 + b) * 6144 + cg * 64 + l] = s;
            }
            __syncthreads();
        }
    }
    {
        const float* lbin = p.in[8]; float* lb = (float*)(ws + OFF_LB);
        for (int i = gtid; i < 512; i += GT) {
            const float a = lbin[i], b = lbin[512 + i], m = fmaxf(a, b);
            const float ea = expf(a - m), eb = expf(b - m);
            lb[i] = ea / (ea + eb);
        }
    }
    {
        const float* are = p.in[10]; const float* aim = p.in[11]; const float* ldt = p.in[12];
        const float* bre = p.in[13]; const float* bim = p.in[14];
        float* AB = (float*)(ws + OFF_S5AB); float* BBR = (float*)(ws + OFF_S5BB); float* BBI = BBR + 32 * 64 * 16;
        for (int i = gtid; i < 2048; i += GT) {
            const int g = i >> 6;
            const double ar = are[i], ai = aim[i], dt = exp((double)ldt[g]);
            const double mag = exp(ar * dt), abr = mag * cos(ai * dt), abi = mag * sin(ai * dt);
            const double den = ar * ar + ai * ai, nr = abr - 1.0, ni = abi;
            const double cr = (nr * ar + ni * ai) / den, ci = (ni * ar - nr * ai) / den;
            const double magL = exp(ar * dt * (double)S5_SEG);
            AB[i] = (float)abr; AB[2048 + i] = (float)abi;
            AB[4096 + i] = (float)(magL * cos(ai * dt * (double)S5_SEG)); AB[6144 + i] = (float)(magL * sin(ai * dt * (double)S5_SEG));
            for (int h = 0; h < 16; ++h) {
                const double br = bre[i * 16 + h], bi = bim[i * 16 + h];
                BBR[i * 16 + h] = (float)(cr * br - ci * bi);
                BBI[i * 16 + h] = (float)(cr * bi + ci * br);
            }
        }
    }
    {
        const float* are = p.in[10]; const float* aim = p.in[11]; const float* ldt = p.in[12];
        const float* bre = p.in[13]; const float* bim = p.in[14];
        bf16_t* H16 = (bf16_t*)(ws + OFF_S5H16); float* W16 = (float*)(ws + OFF_S5W16);
        for (int i = gtid; i < 2048 * 16; i += GT) {
            const int gp = i >> 4, m = i & 15, g = gp >> 6, pp = gp & 63, t = 15 - m;
            const double ar = are[gp], ai = aim[gp], dt = exp((double)ldt[g]);
            const double mag = exp(ar * dt), abr = mag * cos(ai * dt), abi = mag * sin(ai * dt);
            const double den = ar * ar + ai * ai, nr = abr - 1.0, ni = abi;
            const double cr = (nr * ar + ni * ai) / den, ci = (ni * ar - nr * ai) / den;
            const double pm = exp(ar * dt * (double)m), pr = pm * cos(ai * dt * (double)m), pi = pm * sin(ai * dt * (double)m);
            for (int h = 0; h < 16; ++h) {
                const double br = bre[gp * 16 + h], bi = bim[gp * 16 + h];
                const double bbr = cr * br - ci * bi, bbi = cr * bi + ci * br;
                H16[((size_t)(g * 128 + 2 * pp)) * 256 + t * 16 + h] = f2bf((float)(pr * bbr - pi * bbi));
                H16[((size_t)(g * 128 + 2 * pp + 1)) * 256 + t * 16 + h] = f2bf((float)(pr * bbi + pi * bbr));
            }
        }
        for (int i = gtid; i < 2048 * 32; i += GT) {
            const int gp = i >> 5, tile = i & 31, g = gp >> 6;
            const double ar = are[gp], ai = aim[gp], dt = exp((double)ldt[g]), ee = 16.0 * (double)(31 - tile);
            const double pm = exp(ar * dt * ee);
            W16[(size_t)i * 2] = (float)(pm * cos(ai * dt * ee)); W16[(size_t)i * 2 + 1] = (float)(pm * sin(ai * dt * ee));
        }
    }
    transpose_W(p.in[6], (bf16_t*)(ws + OFF_WIN), 1024, 2560, gtid, GT);
    transpose_W(p.in[7], (bf16_t*)(ws + OFF_WOUT), 1024, 1024, gtid, GT);
    transpose_W(p.in[18], (bf16_t*)(ws + OFF_WGLU), 512, 512, gtid, GT);
    transpose_W(p.in[20], (bf16_t*)(ws + OFF_WQ), 1024, 2048, gtid, GT);
    pack_BT(p.in[21], (bf16_t*)(ws + OFF_KEYS), 128, 128, gtid, GT);
    pack_BT(p.in[22], (bf16_t*)(ws + OFF_KEYS) + 128 * 128, 128, 128, gtid, GT);
    cvt_table_fp8(p.in[23], ws + OFF_UT8, (float*)(ws + OFF_ISU), bid * NWAVE + wave, nb * NWAVE, lane);
    cvt_table_fp8(p.in[24], ws + OFF_VT8, (float*)(ws + OFF_ISV), bid * NWAVE + wave, nb * NWAVE, lane);
}

template <bool MIXED>
__device__ __forceinline__ void phase_norm(const Params& p, const float* __restrict__ src, const bf16_t* __restrict__ mix, const float* __restrict__ nw, int sh_off, int sc_off, bf16_t* __restrict__ dst) {
    const int tid = otid(), lane = tid & 63, wave = tid >> 6;
    const int gw = blockIdx.x * NWAVE + wave, GW = gridDim.x * NWAVE;
    const float* mod = (const float*)(p.ws + OFF_MOD);
    const float* modp = (const float*)(p.ws + OFF_MODP);
    if (!MIXED) {
        float* modw = (float*)(p.ws + OFF_MOD);
        for (int i = blockIdx.x * NT + tid; i < 2 * 6144; i += gridDim.x * NT) modw[i] = (modp[i] + modp[12288 + i]) + (modp[2 * 12288 + i] + modp[3 * 12288 + i]);
    }
    for (int b = 0; b < BATCH; ++b) {
        float4 fa[4], fs[4];
#pragma unroll
        for (int j = 0; j < 4; ++j) {
            const int c4 = j * 64 + lane;
            const float4 w = ((const float4*)nw)[c4];
            float4 sc, shv;
            if (!MIXED) {
                const float4* q0 = (const float4*)(modp + b * 6144);
                const float4 s0 = q0[sc_off / 4 + c4], s1 = q0[12288 / 4 + sc_off / 4 + c4], s2 = q0[2 * 12288 / 4 + sc_off / 4 + c4], s3 = q0[3 * 12288 / 4 + sc_off / 4 + c4];
                const float4 h0 = q0[sh_off / 4 + c4], h1 = q0[12288 / 4 + sh_off / 4 + c4], h2 = q0[2 * 12288 / 4 + sh_off / 4 + c4], h3 = q0[3 * 12288 / 4 + sh_off / 4 + c4];
                sc = make_float4((s0.x + s1.x) + (s2.x + s3.x), (s0.y + s1.y) + (s2.y + s3.y), (s0.z + s1.z) + (s2.z + s3.z), (s0.w + s1.w) + (s2.w + s3.w));
                shv = make_float4((h0.x + h1.x) + (h2.x + h3.x), (h0.y + h1.y) + (h2.y + h3.y), (h0.z + h1.z) + (h2.z + h3.z), (h0.w + h1.w) + (h2.w + h3.w));
            } else {
                sc = ((const float4*)(mod + b * 6144 + sc_off))[c4];
                shv = ((const float4*)(mod + b * 6144 + sh_off))[c4];
            }
            fs[j] = shv;
            fa[j] = make_float4(w.x * (1.f + sc.x), w.y * (1.f + sc.y), w.z * (1.f + sc.z), w.w * (1.f + sc.w));
        }
        for (int r = gw; r < SEQ; r += GW) {
            const size_t row = (size_t)b * SEQ + r;
            const float4* xr = (const float4*)(src + row * D);
            float4 v[4];
            float ss = 0.f;
#pragma unroll
            for (int j = 0; j < 4; ++j) {
                v[j] = xr[j * 64 + lane];
                if (MIXED) {
                    const uint2 m = *(const uint2*)(mix + row * D + (size_t)(j * 64 + lane) * 4);
                    const float4 g1 = ((const float4*)(mod + b * 6144 + 2048))[j * 64 + lane];
                    v[j].x += g1.x * bflo(m.x); v[j].y += g1.y * bfhi(m.x); v[j].z += g1.z * bflo(m.y); v[j].w += g1.w * bfhi(m.y);
                }
                ss += v[j].x * v[j].x + v[j].y * v[j].y + v[j].z * v[j].z + v[j].w * v[j].w;
            }
            ss = wave_sum(ss);
            const float rstd = rsqrtf(ss * (1.0f / D) + EPS);
#pragma unroll
            for (int j = 0; j < 4; ++j) {
                const float o0 = v[j].x * rstd * fa[j].x + fs[j].x, o1 = v[j].y * rstd * fa[j].y + fs[j].y;
                const float o2 = v[j].z * rstd * fa[j].z + fs[j].z, o3 = v[j].w * rstd * fa[j].w + fs[j].w;
                *(uint2*)(dst + row * D + (size_t)(j * 64 + lane) * 4) = make_uint2(pack2(o0, o1), pack2(o2, o3));
            }
        }
    }
}

namespace pg8 {
#define PG8_LAS __attribute__((address_space(3)))
typedef unsigned short bf16_t;
typedef short bf16x8 __attribute__((ext_vector_type(8)));
typedef float f32x4 __attribute__((ext_vector_type(4)));
typedef unsigned u32x4 __attribute__((ext_vector_type(4)));
constexpr int BM = 256, BK = 64, HALF = 128, HTB = HALF * BK * 2  , STAGE_BYTES = 8 * HTB, NXCD = 8, WGM = 8;

__host__ __device__ __forceinline__ int lds_byte(int r, int c) { const int st = (r >> 4) * 2 + (c >> 5), rr = r & 15, cc = c & 31, ob = rr * 64 + cc * 2; return st * 1024 + (ob ^ (((ob >> 9) & 1) << 5)); }
__host__ __device__ __forceinline__ void stage_rc(int b, int& R, int& C) { const int st = b / 1024, sb = b % 1024, swz = sb ^ (((sb >> 9) & 1) << 5); R = (st >> 1) * 16 + swz / 64; C = (st & 1) * 32 + (swz % 64) / 2; }
__host__ __device__ __forceinline__ int perm32(int rho) { const int n = rho >> 4, i = rho & 15; return 8 * (i >> 2) + 4 * n + (i & 3); }

struct Unit { int pm, pn; };
struct Gemm { const bf16_t* A; const bf16_t* Bt; int M, N, K; };

struct StaticOrder {
    int nM, nN, nwg, G, c;
    __host__ __device__ void init(int M, int N, int G_, int c_) { nM = M / BM; nN = N / BM; nwg = nM * nN; G = G_; c = c_; }
    __host__ __device__ bool next(int i, Unit& u) const {
        const long L = (long)i * G + c; if (L >= nwg) return false;
        int wgid = (int)L; { const int q = nwg / NXCD, r = nwg % NXCD, xcd = wgid % NXCD, off = wgid / NXCD; wgid = (xcd < r ? xcd * (q + 1) : r * (q + 1) + (xcd - r) * q) + off; }
        const int nig = WGM * nN, gid = wgid / nig, fm = gid * WGM, gsz = (nM - fm) < WGM ? (nM - fm) : WGM;
        u.pm = fm + ((wgid % nig) % gsz); u.pn = (wgid % nig) / gsz; return true;
    }
    __device__ __forceinline__ void a_ready(const Unit&) const {}
    __device__ __forceinline__ void done(const Unit&) const {}
};
__device__ __forceinline__ unsigned cvt_pk_bf16(float lo, float hi) { unsigned r; asm volatile("v_cvt_pk_bf16_f32 %0, %1, %2" : "=v"(r) : "v"(lo), "v"(hi)); return r; }
typedef float f32x2 __attribute__((ext_vector_type(2)));
__device__ __forceinline__ f32x2 gelu_pk(f32x2 v) {
    const f32x2 av = __builtin_elementwise_abs(v), d = av * 0.2316418882f + 1.0f;
    f32x2 t; t.x = __builtin_amdgcn_rcpf(d.x); t.y = __builtin_amdgcn_rcpf(d.y);
    f32x2 q = t * 0.5307027145f + (-0.7265760135f); q = q * t + 0.7107068705f; q = q * t + (-0.142248368f); q = q * t + 0.127414796f; q = q * t;
    const f32x2 s = (v * v) * (-0.72134752044f);
    f32x2 e; e.x = __builtin_amdgcn_exp2f(s.x); e.y = __builtin_amdgcn_exp2f(s.y);
    const f32x2 m = v * (q * e), r = v - m;
    f32x2 o; o.x = v.x < 0.f ? m.x : r.x; o.y = v.y < 0.f ? m.y : r.y; return o;
}
template <int ACT  > struct EpiBf16 {
    static constexpr bool PERM = true, AFTER_DRAIN = false;
    bf16_t* O; int ldc; const float* bias; int split_cols; size_t split_stride;
    __device__ __forceinline__ void operator()(const f32x4 (&acc)[2][2][4][2], const Unit& u, int wr, int wc, int fr, int fq) const {
        const int row0 = u.pm * BM + wr * 64 + fr; int colt = u.pn * BM; bf16_t* base = O;
        if (split_cols) { const int t = colt / split_cols; base += (size_t)t * split_stride; colt -= t * split_cols; }
        const int col0 = colt + wc * 32 + 8 * fq, bcol0 = u.pn * BM + wc * 32 + 8 * fq;
        f32x4 bv[2][2];
#pragma unroll
        for (int bj = 0; bj < 2; ++bj)
#pragma unroll
            for (int n = 0; n < 2; ++n) bv[bj][n] = bias ? *(const f32x4*)(bias + bcol0 + bj * HALF + 4 * n) : (f32x4){0.f, 0.f, 0.f, 0.f};
#pragma unroll
        for (int ai = 0; ai < 2; ++ai)
#pragma unroll
            for (int m = 0; m < 4; ++m) { bf16_t* rowp = base + (size_t)(row0 + ai * HALF + m * 16) * ldc + col0;
#pragma unroll
                for (int bj = 0; bj < 2; ++bj) { f32x4 v0 = acc[ai][bj][m][0] + bv[bj][0], v1 = acc[ai][bj][m][1] + bv[bj][1];
                    if (ACT == 1) { f32x2 a = gelu_pk((f32x2){v0[0], v0[1]}), b = gelu_pk((f32x2){v0[2], v0[3]}), c = gelu_pk((f32x2){v1[0], v1[1]}), d = gelu_pk((f32x2){v1[2], v1[3]});
                        v0 = (f32x4){a.x, a.y, b.x, b.y}; v1 = (f32x4){c.x, c.y, d.x, d.y}; }
                    if (ACT == 2) {
#pragma unroll
                        for (int j = 0; j < 4; ++j) { v0[j] = 0.5f * v0[j] * (1.0f + erff(v0[j] * 0.70710678f)); v1[j] = 0.5f * v1[j] * (1.0f + erff(v1[j] * 0.70710678f)); } }
                    u32x4 w; w.x = cvt_pk_bf16(v0[0], v0[1]); w.y = cvt_pk_bf16(v0[2], v0[3]); w.z = cvt_pk_bf16(v1[0], v1[1]); w.w = cvt_pk_bf16(v1[2], v1[3]);
                    *(u32x4*)(rowp + bj * HALF) = w; } }
    }
};

template <class Epi, class Sched, bool STAMP = false>
__device__ __forceinline__ void gemm_phase(PG8_LAS unsigned char* lds, const Gemm g, const Sched& S, const Epi& E, unsigned long long* stamps) {
    int tid_ = threadIdx.x; asm volatile("" : "+v"(tid_));
    const int tid = tid_, wid = __builtin_amdgcn_readfirstlane(tid >> 6), lane = tid & 63, wr = wid >> 2, wc = wid & 3, fr = lane & 15, fq = lane >> 4;
    const int K = g.K, nt = K / BK;
    int ts_lo = 0, ts_hi = 0, nts = 0; const unsigned long long rt_entry = 0ull;
#define PG8_STAMP() do { if (STAMP && wid == 0 && nts < 64) { const unsigned long long _c = (unsigned long long)clock64(); \
        ts_lo = (lane == nts) ? (int)(unsigned)_c : ts_lo; ts_hi = (lane == nts) ? (int)(unsigned)(_c >> 32) : ts_hi; ++nts; } } while (0)
    PG8_STAMP();
    unsigned voffA[2], voffB[2];
#pragma unroll
    for (int i = 0; i < 2; ++i) { int R, C; stage_rc(tid * 16 + i * 8192, R, C); const int Rb = Epi::PERM ? ((R & ~31) + perm32(R & 31)) : R;
        voffA[i] = (unsigned)(R * K + C) * 2u; voffB[i] = (unsigned)(Rb * K + C) * 2u; }
    const size_t kstep = (size_t)(BK * 2);
    const size_t hstep = (size_t)HALF * K * 2;
    const size_t tstep = 2 * hstep;
    const unsigned ldsw = (unsigned)wid * 1024u;
    const int aoff = lds_byte(wr * 64 + fr, fq * 8), boff = lds_byte(wc * 32 + fr, fq * 8);
#define PG8_SA(b, h) (((b) * 2 + (h)) * HTB)
#define PG8_SB(b, h) ((4 + (b) * 2 + (h)) * HTB)
#define PG8_STAGE(bufoff, gbase, voff) do { _Pragma("unroll") for (int _i = 0; _i < 2; ++_i) \
        __builtin_amdgcn_global_load_lds((const unsigned*)((const char*)(gbase) + (voff)[_i]), (PG8_LAS unsigned*)(lds + (bufoff) + ldsw + _i * 8192), 16, 0, 0); } while (0)
#define PG8_LDA(dst, b, h) do { _Pragma("unroll") for (int m = 0; m < 4; ++m) _Pragma("unroll") for (int k = 0; k < 2; ++k) dst[m][k] = *(const PG8_LAS bf16x8*)(lds + PG8_SA(b, h) + aoff + m * 2048 + k * 1024); } while (0)
#define PG8_LDB(dst, b, h) do { _Pragma("unroll") for (int n = 0; n < 2; ++n) _Pragma("unroll") for (int k = 0; k < 2; ++k) dst[n][k] = *(const PG8_LAS bf16x8*)(lds + PG8_SB(b, h) + boff + n * 2048 + k * 1024); } while (0)
#define PG8_MMA(ai, bj, At, Bt) do { __builtin_amdgcn_s_setprio(1); _Pragma("unroll") for (int m = 0; m < 4; ++m) _Pragma("unroll") for (int n = 0; n < 2; ++n) _Pragma("unroll") for (int k = 0; k < 2; ++k) \
        acc[ai][bj][m][n] = __builtin_amdgcn_mfma_f32_16x16x32_bf16(Bt[n][k], At[m][k], acc[ai][bj][m][n], 0, 0, 0); __builtin_amdgcn_s_setprio(0); } while (0)
#define PG8_WAIT_V(n) asm volatile("s_waitcnt vmcnt(" #n ")" ::: "memory")
#define PG8_WAIT_L(n) asm volatile("s_waitcnt lgkmcnt(" #n ")" ::: "memory")
#define PG8_BAR __builtin_amdgcn_s_barrier()
#define PG8_SCHED __builtin_amdgcn_sched_barrier(0)
    Unit cur, nxt; int ui = 0;
    if (!S.next(0, cur)) return;
    f32x4 acc[2][2][4][2];
#pragma unroll
    for (int a = 0; a < 2; ++a)
#pragma unroll
        for (int b = 0; b < 2; ++b)
#pragma unroll
            for (int m = 0; m < 4; ++m)
#pragma unroll
                for (int n = 0; n < 2; ++n) acc[a][b][m][n] = (f32x4){0.f, 0.f, 0.f, 0.f};
    bf16x8 At[4][2], B0[2][2], B1[2][2];
    const char* cA = (const char*)g.A + (size_t)cur.pm * tstep; const char* cB = (const char*)g.Bt + (size_t)cur.pn * tstep;
    S.a_ready(cur);
    PG8_STAGE(PG8_SB(0, 0), cB, voffB); PG8_STAGE(PG8_SA(0, 0), cA, voffA); PG8_STAGE(PG8_SB(0, 1), cB + hstep, voffB); PG8_STAGE(PG8_SA(0, 1), cA + hstep, voffA);
    if (wr == 1) PG8_BAR;
    PG8_WAIT_V(4); PG8_BAR;
    PG8_STAGE(PG8_SB(1, 0), cB + kstep, voffB); PG8_STAGE(PG8_SA(1, 0), cA + kstep, voffA); PG8_STAGE(PG8_SB(1, 1), cB + hstep + kstep, voffB);
    PG8_WAIT_V(6); PG8_BAR;
    PG8_STAMP();
    for (;;) {
        const bool has_next = S.next(ui + 1, nxt);
        const char* nA = has_next ? (const char*)g.A + (size_t)nxt.pm * tstep : cA; const char* nB = has_next ? (const char*)g.Bt + (size_t)nxt.pn * tstep : cB;
        for (int t = 0; t < nt; t += 2) {
            const bool last = (t == nt - 2);
            const char* a1 = cA + (size_t)(t + 1) * kstep;
            const char* a2 = last ? nA : cA + (size_t)(t + 2) * kstep; const char* b2 = last ? nB : cB + (size_t)(t + 2) * kstep;
            const char* a3 = a2 + kstep; const char* b3 = b2 + kstep;
            if (last && has_next) S.a_ready(nxt);
            PG8_LDB(B0, 0, 0); PG8_SCHED; PG8_LDA(At, 0, 0); PG8_STAGE(PG8_SA(1, 1), a1 + hstep, voffA);
            PG8_WAIT_L(8); PG8_BAR; PG8_WAIT_L(0); PG8_MMA(0, 0, At, B0); PG8_BAR; PG8_SCHED;
            PG8_LDB(B1, 0, 1); PG8_STAGE(PG8_SB(0, 0), b2, voffB);
            PG8_BAR; PG8_WAIT_L(0); PG8_MMA(0, 1, At, B1); PG8_BAR;
            PG8_LDA(At, 0, 1); PG8_STAGE(PG8_SA(0, 0), a2, voffA);
            PG8_BAR; PG8_WAIT_L(0); PG8_MMA(1, 0, At, B0); PG8_BAR; PG8_SCHED;
            PG8_STAGE(PG8_SB(0, 1), b2 + hstep, voffB);
            PG8_WAIT_V(6); PG8_BAR; PG8_MMA(1, 1, At, B1); PG8_BAR;
            PG8_LDB(B0, 1, 0); PG8_SCHED; PG8_LDA(At, 1, 0); PG8_STAGE(PG8_SA(0, 1), a2 + hstep, voffA);
            PG8_WAIT_L(8); PG8_BAR; PG8_WAIT_L(0); PG8_MMA(0, 0, At, B0); PG8_BAR; PG8_SCHED;
            PG8_LDB(B1, 1, 1); PG8_STAGE(PG8_SB(1, 0), b3, voffB);
            PG8_BAR; PG8_WAIT_L(0); PG8_MMA(0, 1, At, B1); PG8_BAR;
            PG8_LDA(At, 1, 1); PG8_STAGE(PG8_SA(1, 0), a3, voffA);
            PG8_BAR; PG8_WAIT_L(0); PG8_MMA(1, 0, At, B0); PG8_BAR; PG8_SCHED;
            PG8_STAGE(PG8_SB(1, 1), b3 + hstep, voffB);
            PG8_WAIT_V(6); PG8_BAR; PG8_MMA(1, 1, At, B1); PG8_BAR;
        }
        PG8_STAMP();
        if constexpr (!Epi::AFTER_DRAIN) { E(acc, cur, wr, wc, fr, fq); S.done(cur); }
        PG8_STAMP();
        if (!has_next) break;
#pragma unroll
        for (int a = 0; a < 2; ++a)
#pragma unroll
            for (int b = 0; b < 2; ++b)
#pragma unroll
                for (int m = 0; m < 4; ++m)
#pragma unroll
                    for (int n = 0; n < 2; ++n) acc[a][b][m][n] = (f32x4){0.f, 0.f, 0.f, 0.f};
        cur = nxt; cA = nA; cB = nB; ++ui;
    }
    PG8_WAIT_V(0);
    if (wr == 0) PG8_BAR;
    PG8_BAR;
    if constexpr (Epi::AFTER_DRAIN) { E.fused(acc, cur, wr, wc, fr, fq, lds, wid, lane); S.done(cur); }
    PG8_STAMP();
    if (STAMP && wid == 0) { stamps[lane] = lane < nts ? (((unsigned long long)(unsigned)ts_hi << 32) | (unsigned)ts_lo) : 0ull;
        if (lane == 62) stamps[62] = rt_entry; }
#undef PG8_STAMP
#undef PG8_SA
#undef PG8_SB
#undef PG8_STAGE
#undef PG8_LDA
#undef PG8_LDB
#undef PG8_MMA
#undef PG8_WAIT_V
#undef PG8_WAIT_L
#undef PG8_BAR
#undef PG8_SCHED
}
}

struct EpiGlu {
    static constexpr bool PERM = true, AFTER_DRAIN = false;
    const bf16_t* YG; const float* bias; bf16_t* OC;
    __device__ __forceinline__ void operator()(const pg8::f32x4 (&acc)[2][2][4][2], const pg8::Unit& u, int wr, int wc, int fr, int fq) const {
        const int row0 = u.pm * 256 + wr * 64 + fr, col0 = u.pn * 256 + wc * 32 + 8 * fq;
#pragma unroll
        for (int ai = 0; ai < 2; ++ai)
#pragma unroll
            for (int m = 0; m < 4; ++m) {
                const size_t row = (size_t)(row0 + ai * 128 + m * 16);
#pragma unroll
                for (int bj = 0; bj < 2; ++bj) {
                    const int col = col0 + bj * 128;
                    const uint4 yv = *(const uint4*)(YG + row * 512 + col);
                    const float4 b0 = *(const float4*)(bias + col), b1 = *(const float4*)(bias + col + 4);
                    const pg8::f32x4 v0 = acc[ai][bj][m][0], v1 = acc[ai][bj][m][1];
                    const float o0 = bflo(yv.x) * sigmoidf_(v0[0] + b0.x), o1 = bfhi(yv.x) * sigmoidf_(v0[1] + b0.y);
                    const float o2 = bflo(yv.y) * sigmoidf_(v0[2] + b0.z), o3 = bfhi(yv.y) * sigmoidf_(v0[3] + b0.w);
                    const float o4 = bflo(yv.z) * sigmoidf_(v1[0] + b1.x), o5 = bfhi(yv.z) * sigmoidf_(v1[1] + b1.y);
                    const float o6 = bflo(yv.w) * sigmoidf_(v1[2] + b1.z), o7 = bfhi(yv.w) * sigmoidf_(v1[3] + b1.w);
                    *(uint4*)(OC + row * 1024 + 512 + col) = make_uint4(pack2(o0, o1), pack2(o2, o3), pack2(o4, o5), pack2(o6, o7));
                }
            }
    }
};
template <class Epi>
__device__ __forceinline__ void gemm_run(unsigned char* lds, const bf16_t* A, const bf16_t* Bt, int M, int N, int K, const Epi& E) {
    pg8::Gemm g{A, Bt, M, N, K};
    pg8::StaticOrder S; S.init(M, N, (int)gridDim.x, (int)blockIdx.x);
    pg8::gemm_phase<Epi, pg8::StaticOrder, false>((PG8_LAS unsigned char*)lds, g, S, E, nullptr);
}

constexpr int HQ = 136;
constexpr int HV = 72;
constexpr int HL = 132;
constexpr int HG_L = 0, HG_OFFS = 33792, HG_RS = 35840, HG_QT = 36864, HG_KT = 54272, HG_VT = 71680, HG_ST = 90112, HG_SC = 124928;
__device__ __forceinline__ unsigned rawpack(bf16_t a, bf16_t b) { return (unsigned)a | ((unsigned)b << 16); }
struct HgIn { u32x2_t q[4], z[4], v[4]; };
__device__ __forceinline__ void hg_load(const Params& p, int unit, int tid, HgIn& in, bool want_q) {
    const bf16_t* PROJ = (const bf16_t*)(p.ws + OFF_PROJ);
    const int c = unit & 255, h = (unit >> 8) & 3, b = unit >> 10;
    const int tok0 = b * SEQ + c * 64;
#pragma unroll
    for (int j = 0; j < 4; ++j) {
        const int e4 = tid + NT * j, t = e4 >> 5, k4 = (e4 & 31) * 4;
        const size_t base = (size_t)(tok0 + t) * INW + h * 128 + k4;
        if (want_q) in.q[j] = *(const u32x2_t*)(PROJ + base);
        in.z[j] = *(const u32x2_t*)(PROJ + base + 512);
        in.v[j] = *(const u32x2_t*)(PROJ + base + 1024);
    }
}
__device__ __forceinline__ void hg_cumsum(unsigned char* lds, const HgIn& in, const float4 l4) {
    const int tid = otid();
    float* L = (float*)(lds + HG_L); float* OFFS = (float*)(lds + HG_OFFS);
#pragma unroll
    for (int j = 0; j < 4; ++j) {
        const int e4 = tid + NT * j, t = e4 >> 5, k4 = (e4 & 31) * 4;
        const u32x2_t zz = in.z[j];
        float4 o;
        o.x = flog(1.f - (1.f - l4.x) * sigmoidf_(-bflo(zz.x))); o.y = flog(1.f - (1.f - l4.y) * sigmoidf_(-bfhi(zz.x)));
        o.z = flog(1.f - (1.f - l4.z) * sigmoidf_(-bflo(zz.y))); o.w = flog(1.f - (1.f - l4.w) * sigmoidf_(-bfhi(zz.y)));
        *(float4*)(L + t * HL + k4) = o;
    }
    __syncthreads();
    const int k = tid & 127, sg = tid >> 7;
    {
        float s = 0.f;
#pragma unroll
        for (int i = 0; i < 16; ++i) { const int t = sg * 16 + i; s += L[t * HL + k]; L[t * HL + k] = s; }
    }
    __syncthreads();
    {
        float off = 0.f;
#pragma unroll
        for (int s2 = 0; s2 < 3; ++s2) if (s2 < sg) off += L[(s2 * 16 + 15) * HL + k];
        OFFS[sg * 128 + k] = off;
    }
    __syncthreads();
}

__device__ __forceinline__ void phase_hg1(const Params& p, unsigned char* lds) {
    const int tid = otid(), lane = tid & 63, wave = tid >> 6, fr = lane & 15, fq = lane >> 4;
    const float* L = (const float*)(lds + HG_L); const float* OFFS = (const float*)(lds + HG_OFFS);
    bf16_t* VT = (bf16_t*)(lds + HG_VT); bf16_t* KET = (bf16_t*)(lds + HG_ST);
    const float* lb = (const float*)(p.ws + OFF_LB);
    bf16_t* HGS = (bf16_t*)(p.ws + OFF_HGS);
    float* DEC = (float*)(p.ws + OFF_HGDEC);
    HgIn in;
    hg_load(p, (int)blockIdx.x < 2048 ? (int)blockIdx.x : 0, tid, in, false);
    for (int unit = blockIdx.x; unit < 2048; unit += gridDim.x) {
        const int h = (unit >> 8) & 3;
        const float4 l4 = *(const float4*)(lb + h * 128 + (tid & 31) * 4);
        hg_cumsum(lds, in, l4);
#pragma unroll
        for (int j = 0; j < 4; ++j) {
            const int e4 = tid + NT * j, t = e4 >> 5, k4 = (e4 & 31) * 4;
            const u32x2_t zz = in.z[j], vv = in.v[j];
            const float4 bc = *(const float4*)(L + t * HL + k4), of = *(const float4*)(OFFS + (t >> 4) * 128 + k4);
            const float4 bl = *(const float4*)(L + 63 * HL + k4), ol = *(const float4*)(OFFS + 3 * 128 + k4);
            const float zf[4] = {bflo(zz.x), bfhi(zz.x), bflo(zz.y), bfhi(zz.y)};
            const float lv[4] = {l4.x, l4.y, l4.z, l4.w};
            const float bcv[4] = {bc.x + of.x, bc.y + of.y, bc.z + of.z, bc.w + of.w};
            const float blv[4] = {bl.x + ol.x, bl.y + ol.y, bl.z + ol.z, bl.w + ol.w};
            const bf16_t vr[4] = {(bf16_t)(vv.x & 0xffffu), (bf16_t)(vv.x >> 16), (bf16_t)(vv.y & 0xffffu), (bf16_t)(vv.y >> 16)};
#pragma unroll
            for (int i = 0; i < 4; ++i) {
                const float kk = (1.f - lv[i]) * sigmoidf_(-zf[i]);
                KET[(k4 + i) * HV + t] = f2bf(kk * fexp(blv[i] - bcv[i]));
                VT[(k4 + i) * HV + t] = vr[i];
                if (t == 63) DEC[unit * 128 + k4 + i] = fexp(blv[i]);
            }
        }
        hg_load(p, (unit + (int)gridDim.x < 2048) ? unit + (int)gridDim.x : unit, tid, in, false);
        __syncthreads();
        f32x4 acc[8];
#pragma unroll
        for (int n = 0; n < 8; ++n) acc[n] = (f32x4){0.f, 0.f, 0.f, 0.f};
#pragma unroll
        for (int kt = 0; kt < 2; ++kt) {
            const bf16x8 a = *(const bf16x8*)(KET + (wave * 16 + fr) * HV + kt * 32 + 8 * fq);
#pragma unroll
            for (int n = 0; n < 8; ++n) {
                const bf16x8 bb = *(const bf16x8*)(VT + (n * 16 + fr) * HV + kt * 32 + 8 * fq);
                acc[n] = __builtin_amdgcn_mfma_f32_16x16x32_bf16(a, bb, acc[n], 0, 0, 0);
            }
        }
#pragma unroll
        for (int n = 0; n < 8; ++n)
            *(uint2*)(HGS + (size_t)unit * 16384 + (size_t)(n * 16 + fr) * 128 + wave * 16 + 4 * fq) = make_uint2(pack2(acc[n][0], acc[n][1]), pack2(acc[n][2], acc[n][3]));
        __syncthreads();
    }
}

__device__ __forceinline__ void phase_hg2(const Params& p) {
    const int gtid = blockIdx.x * NT + otid(), GT = gridDim.x * NT;
    const bf16_t* __restrict__ HGS = (const bf16_t*)(p.ws + OFF_HGS);
    bf16_t* __restrict__ SST = (bf16_t*)(p.ws + OFF_H);
    const float* __restrict__ DEC = (const float*)(p.ws + OFF_HGDEC);
    for (int idx = gtid; idx < 8 * 16384; idx += GT) {
        const int bh = idx >> 14, kv = idx & 16383, k = kv & 127;
        float s = 0.f;
#pragma unroll 8
        for (int c = 0; c < 256; ++c) {
            const size_t unit = (size_t)bh * 256 + c;
            const float loc = bf2f(HGS[unit * 16384 + kv]);
            const float d = DEC[unit * 128 + k];
            SST[unit * 16384 + kv] = f2bf(s);
            s = d * s + loc;
        }
    }
}

__device__ __forceinline__ void phase_hg3(const Params& p, unsigned char* lds) {
    const int tid = otid(), lane = tid & 63, wave = tid >> 6, fr = lane & 15, fq = lane >> 4;
    const float* L = (const float*)(lds + HG_L); const float* OFFS = (const float*)(lds + HG_OFFS); float* RS = (float*)(lds + HG_RS);
    bf16_t* QT = (bf16_t*)(lds + HG_QT); bf16_t* KT = (bf16_t*)(lds + HG_KT); bf16_t* VT = (bf16_t*)(lds + HG_VT);
    bf16_t* ST = (bf16_t*)(lds + HG_ST); bf16_t* SC = (bf16_t*)(lds + HG_SC);
    const bf16_t* PROJ = (const bf16_t*)(p.ws + OFF_PROJ);
    const float* lb = (const float*)(p.ws + OFF_LB);
    const bf16_t* SST = (const bf16_t*)(p.ws + OFF_H);
    bf16_t* OCAT = (bf16_t*)(p.ws + OFF_OCAT);
    const float* gnw = p.in[9];
    float gn4[4];
#pragma unroll
    for (int jn = 0; jn < 4; ++jn) gn4[jn] = gnw[((wave >> 2) * 4 + jn) * 16 + fr];
    HgIn in; u32x4_t sq[4];
    {
        const int u0 = (int)blockIdx.x < 2048 ? (int)blockIdx.x : 0;
        hg_load(p, u0, tid, in, true);
#pragma unroll
        for (int j = 0; j < 4; ++j) { const int ci = tid + NT * j; sq[j] = *(const u32x4_t*)(SST + (size_t)u0 * 16384 + (ci >> 4) * 128 + (ci & 15) * 8); }
    }
    for (int unit = blockIdx.x; unit < 2048; unit += gridDim.x) {
        const int c = unit & 255, h = (unit >> 8) & 3, b = unit >> 10;
        const int tok0 = b * SEQ + c * 64;
        const float4 l4 = *(const float4*)(lb + h * 128 + (tid & 31) * 4);
        hg_cumsum(lds, in, l4);
#pragma unroll
        for (int j = 0; j < 4; ++j) {
            const int e4 = tid + NT * j, t = e4 >> 5, k4 = (e4 & 31) * 4;
            const u32x2_t qq = in.q[j], zz = in.z[j], vv = in.v[j];
            const float4 bc = *(const float4*)(L + t * HL + k4), of = *(const float4*)(OFFS + (t >> 4) * 128 + k4);
            const float qf[4] = {bflo(qq.x), bfhi(qq.x), bflo(qq.y), bfhi(qq.y)};
            const float zf[4] = {bflo(zz.x), bfhi(zz.x), bflo(zz.y), bfhi(zz.y)};
            const float lv[4] = {l4.x, l4.y, l4.z, l4.w};
            const float bcv[4] = {bc.x + of.x, bc.y + of.y, bc.z + of.z, bc.w + of.w};
            const bf16_t vr[4] = {(bf16_t)(vv.x & 0xffffu), (bf16_t)(vv.x >> 16), (bf16_t)(vv.y & 0xffffu), (bf16_t)(vv.y >> 16)};
            float qt[4], kt[4];
#pragma unroll
            for (int i = 0; i < 4; ++i) {
                const float kk = (1.f - lv[i]) * sigmoidf_(-zf[i]);
                qt[i] = siluf_(qf[i]) * 0.08838834764831845f * fexp(bcv[i]);
                kt[i] = kk * fexp(-bcv[i]);
                VT[(k4 + i) * HV + t] = vr[i];
            }
            *(uint2*)(QT + t * HQ + k4) = make_uint2(pack2(qt[0], qt[1]), pack2(qt[2], qt[3]));
            *(uint2*)(KT + t * HQ + k4) = make_uint2(pack2(kt[0], kt[1]), pack2(kt[2], kt[3]));
        }
#pragma unroll
        for (int j = 0; j < 4; ++j) { const int ci = tid + NT * j; *(u32x4_t*)(ST + (ci >> 4) * HQ + (ci & 15) * 8) = sq[j]; }
        {
            const int un = (unit + (int)gridDim.x < 2048) ? unit + (int)gridDim.x : unit;
            hg_load(p, un, tid, in, true);
#pragma unroll
            for (int j = 0; j < 4; ++j) { const int ci = tid + NT * j; sq[j] = *(const u32x4_t*)(SST + (size_t)un * 16384 + (ci >> 4) * 128 + (ci & 15) * 8); }
        }
        bf16_t gq[4][4];
#pragma unroll
        for (int r = 0; r < 4; ++r)
#pragma unroll
            for (int jn = 0; jn < 4; ++jn)
                gq[r][jn] = PROJ[(size_t)(tok0 + (wave & 3) * 16 + 4 * fq + r) * INW + 1536 + h * 128 + ((wave >> 2) * 4 + jn) * 16 + fr];
        __syncthreads();
        {
            const int mt = wave >> 1;
            bf16x8 aq[4];
#pragma unroll
            for (int kt = 0; kt < 4; ++kt) aq[kt] = *(const bf16x8*)(QT + (mt * 16 + fr) * HQ + kt * 32 + 8 * fq);
#pragma unroll
            for (int jn = 0; jn < 2; ++jn) {
                const int nt = 2 * (wave & 1) + jn;
                f32x4 acc = (f32x4){0.f, 0.f, 0.f, 0.f};
                if (nt <= mt) {
#pragma unroll
                    for (int kt = 0; kt < 4; ++kt) {
                        const bf16x8 bk = *(const bf16x8*)(KT + (nt * 16 + fr) * HQ + kt * 32 + 8 * fq);
                        acc = __builtin_amdgcn_mfma_f32_16x16x32_bf16(aq[kt], bk, acc, 0, 0, 0);
                    }
                }
#pragma unroll
                for (int r = 0; r < 4; ++r) {
                    const int t = mt * 16 + 4 * fq + r, s = nt * 16 + fr;
                    SC[t * HV + s] = f2bf((s <= t) ? acc[r] : 0.f);
                }
            }
        }
        __syncthreads();
        const int mt = wave & 3, ntb = (wave >> 2) * 4;
        f32x4 acc[4];
        {
            bf16x8 aq[4], as[2];
#pragma unroll
            for (int kt = 0; kt < 4; ++kt) aq[kt] = *(const bf16x8*)(QT + (mt * 16 + fr) * HQ + kt * 32 + 8 * fq);
#pragma unroll
            for (int kt = 0; kt < 2; ++kt) as[kt] = *(const bf16x8*)(SC + (mt * 16 + fr) * HV + kt * 32 + 8 * fq);
#pragma unroll
            for (int jn = 0; jn < 4; ++jn) {
                acc[jn] = (f32x4){0.f, 0.f, 0.f, 0.f};
                const int nt = ntb + jn;
#pragma unroll
                for (int kt = 0; kt < 4; ++kt) {
                    const bf16x8 bs = *(const bf16x8*)(ST + (nt * 16 + fr) * HQ + kt * 32 + 8 * fq);
                    acc[jn] = __builtin_amdgcn_mfma_f32_16x16x32_bf16(aq[kt], bs, acc[jn], 0, 0, 0);
                }
#pragma unroll
                for (int kt = 0; kt < 2; ++kt) {
                    const bf16x8 bv = *(const bf16x8*)(VT + (nt * 16 + fr) * HV + kt * 32 + 8 * fq);
                    acc[jn] = __builtin_amdgcn_mfma_f32_16x16x32_bf16(as[kt], bv, acc[jn], 0, 0, 0);
                }
            }
        }
        float ssq[4];
#pragma unroll
        for (int r = 0; r < 4; ++r) {
            float s = 0.f;
#pragma unroll
            for (int jn = 0; jn < 4; ++jn) s += acc[jn][r] * acc[jn][r];
            s += __shfl_xor(s, 1, 64); s += __shfl_xor(s, 2, 64); s += __shfl_xor(s, 4, 64); s += __shfl_xor(s, 8, 64);
            ssq[r] = s;
            if (fr == 0) RS[wave * 16 + 4 * fq + r] = s;
        }
        __syncthreads();
#pragma unroll
        for (int r = 0; r < 4; ++r) {
            const float tot = ssq[r] + RS[(wave ^ 4) * 16 + 4 * fq + r];
            const float rstd = rsqrtf(tot * (1.0f / 128.0f) + EPS);
            const int t = mt * 16 + 4 * fq + r;
#pragma unroll
            for (int jn = 0; jn < 4; ++jn) {
                const int v = (ntb + jn) * 16 + fr;
                OCAT[(size_t)(tok0 + t) * 1024 + h * 128 + v] = f2bf(acc[jn][r] * rstd * gn4[jn] * siluf_(bf2f(gq[r][jn])));
            }
        }
        __syncthreads();
    }
}

__device__ __forceinline__ void lds_barrier() { asm volatile("s_waitcnt lgkmcnt(0)" ::: "memory"); }
constexpr int XS = 136;
constexpr int BS = 132;
constexpr int S5_WAVE_LDS = 16 * BS * 4 + 16 * XS * 2 + 512 + 512;
template <bool FINAL>
__device__ __forceinline__ void phase_s5_scan(const Params& p, unsigned char* lds) {
    const int tid = otid(), lane = tid & 63, wave = tid >> 6, fr = lane & 15, fq = lane >> 4;
    float* BUs = (float*)(lds + wave * S5_WAVE_LDS);
    bf16_t* Xw = (bf16_t*)(lds + wave * S5_WAVE_LDS + 16 * BS * 4);
    bf16_t* U16 = Xw + 16 * XS;
    bf16_t* Y16 = U16 + 256;
    const bf16_t* PROJ = (const bf16_t*)(p.ws + OFF_PROJ);
    const float* AB = (const float*)(p.ws + OFF_S5AB);
    const float* BBR = (const float*)(p.ws + OFF_S5BB); const float* BBI = BBR + 32 * 64 * 16;
    float* END = (float*)(p.ws + OFF_S5END);
    const float* CAR = (const float*)(p.ws + OFF_S5CAR);
    bf16_t* YG = (bf16_t*)(p.ws + OFF_YG);
    const float* cre_g = p.in[15]; const float* cim_g = p.in[16]; const float* dsk = p.in[17];
    for (int item = blockIdx.x; item < 256; item += gridDim.x) {
        const int unit = item * NWAVE + wave;
        const int seg = unit & 31, g = (unit >> 5) & 31, b = unit >> 10;
        bf16x8 bbf[8];
#pragma unroll
        for (int nt = 0; nt < 8; ++nt) {
            const int pp = 8 * nt + (fr >> 1);
            const float* bs = ((fr & 1) ? BBI : BBR) + (size_t)(g * 64 + pp) * 16 + 8 * (fq & 1);
            const float4 c0 = *(const float4*)bs, c1 = *(const float4*)(bs + 4);
            const uint4 wv = (fq < 2) ? make_uint4(pack2(c0.x, c0.y), pack2(c0.z, c0.w), pack2(c1.x, c1.y), pack2(c1.z, c1.w)) : make_uint4(0u, 0u, 0u, 0u);
            bbf[nt] = __builtin_bit_cast(bf16x8, wv);
        }
        bf16x8 cb[4];
        float dskh = 0.f;
        if (FINAL) {
#pragma unroll
            for (int kt = 0; kt < 4; ++kt) {
                const float* cs = ((kt < 2) ? cre_g : cim_g) + (size_t)(g * 16 + fr) * 64 + (kt & 1) * 32 + 8 * fq;
                const float sg = (kt < 2) ? 1.f : -1.f;
                const float4 c0 = *(const float4*)cs, c1 = *(const float4*)(cs + 4);
                const uint4 wv = make_uint4(pack2(sg * c0.x, sg * c0.y), pack2(sg * c0.z, sg * c0.w), pack2(sg * c1.x, sg * c1.y), pack2(sg * c1.z, sg * c1.w));
                cb[kt] = __builtin_bit_cast(bf16x8, wv);
            }
            dskh = dsk[g * 16 + fr];
        }
        const float are = AB[g * 64 + lane], aim = AB[2048 + g * 64 + lane];
        float xr = 0.f, xi = 0.f;
        const size_t sidx = (((size_t)b * 32 + g) * 32 + seg) * 128 + lane * 2;
        if (FINAL) { xr = CAR[sidx]; xi = CAR[sidx + 1]; }
        const int tok_seg = b * SEQ + seg * S5_SEG;
        const bf16_t* ubase = PROJ + (size_t)(tok_seg + fr) * INW + 2048 + g * 16 + 8 * (fq & 1);
        u32x4_t ua = *(const u32x4_t*)ubase, ub = *(const u32x4_t*)(ubase + (size_t)16 * INW);
        for (int tile = 0; tile < S5_SEG / 16; ++tile) {
            const int tokbase = tok_seg + tile * 16;
            if (FINAL && tile > 0 && lane < 32) *(u32x4_t*)(YG + (size_t)(tokbase - 16 + (lane >> 1)) * 512 + g * 16 + 8 * (lane & 1)) = *(const u32x4_t*)(Y16 + (lane >> 1) * 16 + 8 * (lane & 1));
            const u32x4_t uz = {0u, 0u, 0u, 0u};
            const bf16x8 af = __builtin_bit_cast(bf16x8, (fq < 2) ? ua : uz);
            if (FINAL && fq < 2) *(u32x4_t*)(U16 + fr * 16 + 8 * fq) = ua;
            ua = ub;
            if (tile + 2 < S5_SEG / 16) ub = *(const u32x4_t*)(ubase + (size_t)(tile + 2) * 16 * INW);
#pragma unroll
            for (int nt = 0; nt < 8; ++nt) {
                f32x4 acc = (f32x4){0.f, 0.f, 0.f, 0.f};
                acc = __builtin_amdgcn_mfma_f32_16x16x32_bf16(af, bbf[nt], acc, 0, 0, 0);
#pragma unroll
                for (int r = 0; r < 4; ++r) BUs[(4 * fq + r) * BS + nt * 16 + fr] = acc[r];
            }
            lds_barrier();
            float2 bu[16];
#pragma unroll
            for (int t = 0; t < 16; ++t) bu[t] = *(const float2*)(BUs + t * BS + 2 * lane);
            __builtin_amdgcn_sched_barrier(0);
#pragma unroll
            for (int t = 0; t < 16; ++t) {
                const float nxr = are * xr - aim * xi + bu[t].x;
                const float nxi = are * xi + aim * xr + bu[t].y;
                xr = nxr; xi = nxi;
                if (FINAL) { Xw[t * XS + lane] = f2bf(xr); Xw[t * XS + 64 + lane] = f2bf(xi); }
            }
            lds_barrier();
            if (FINAL) {
                f32x4 acc = (f32x4){0.f, 0.f, 0.f, 0.f};
#pragma unroll
                for (int kt = 0; kt < 4; ++kt) {
                    const bf16x8 a = *(const bf16x8*)(Xw + fr * XS + kt * 32 + 8 * fq);
                    acc = __builtin_amdgcn_mfma_f32_16x16x32_bf16(a, cb[kt], acc, 0, 0, 0);
                }
#pragma unroll
                for (int r = 0; r < 4; ++r) {
                    const int tl = 4 * fq + r;
                    Y16[tl * 16 + fr] = f2bf(geluf_(acc[r] + dskh * bf2f(U16[tl * 16 + fr])));
                }
                lds_barrier();
            }
        }
        if (FINAL) {
            if (lane < 32) *(u32x4_t*)(YG + (size_t)(tok_seg + S5_SEG - 16 + (lane >> 1)) * 512 + g * 16 + 8 * (lane & 1)) = *(const u32x4_t*)(Y16 + (lane >> 1) * 16 + 8 * (lane & 1));
            lds_barrier();
        }
        if (!FINAL) { END[sidx] = xr; END[sidx + 1] = xi; }
    }
}
constexpr int H16S = 264;
__device__ __forceinline__ void phase_s5_end(const Params& p, unsigned char* lds) {
    const int tid = otid(), lane = tid & 63, wave = tid >> 6, fr = lane & 15, fq = lane >> 4;
    const bf16_t* PROJ = (const bf16_t*)(p.ws + OFF_PROJ);
    const bf16_t* H16 = (const bf16_t*)(p.ws + OFF_S5H16); const float* W16 = (const float*)(p.ws + OFF_S5W16);
    float* END = (float*)(p.ws + OFF_S5END);
    bf16_t* HL = (bf16_t*)lds;
    for (int item = blockIdx.x; item < 256; item += gridDim.x) {
        const int unit = item * NWAVE + wave;
        const int seg = unit & 31, g = (unit >> 5) & 31, b = unit >> 10;
        const int tok_seg = b * SEQ + seg * S5_SEG;
        bf16x8 bu[8][2];
#pragma unroll
        for (int ks = 0; ks < 8; ++ks)
#pragma unroll
            for (int nt = 0; nt < 2; ++nt) bu[ks][nt] = *(const bf16x8*)(PROJ + (size_t)(tok_seg + (nt * 16 + fr) * 16 + 2 * ks + (fq >> 1)) * INW + 2048 + g * 16 + 8 * (fq & 1));
        __syncthreads();
#pragma unroll
        for (int j = 0; j < 8; ++j) { const int ci = tid + NT * j, row = ci >> 5, c8 = (ci & 31) * 8; *(u32x4_t*)(HL + row * H16S + c8) = *(const u32x4_t*)(H16 + ((size_t)(g * 128 + row)) * 256 + c8); }
        __syncthreads();
        f32x4 acc[8][2];
#pragma unroll
        for (int mt = 0; mt < 8; ++mt) { acc[mt][0] = (f32x4){0.f, 0.f, 0.f, 0.f}; acc[mt][1] = (f32x4){0.f, 0.f, 0.f, 0.f}; }
#pragma unroll
        for (int ks = 0; ks < 8; ++ks)
#pragma unroll
            for (int mt = 0; mt < 8; ++mt) {
                const bf16x8 a = *(const bf16x8*)(HL + (mt * 16 + fr) * H16S + ks * 32 + 8 * fq);
                acc[mt][0] = __builtin_amdgcn_mfma_f32_16x16x32_bf16(a, bu[ks][0], acc[mt][0], 0, 0, 0);
                acc[mt][1] = __builtin_amdgcn_mfma_f32_16x16x32_bf16(a, bu[ks][1], acc[mt][1], 0, 0, 0);
            }
#pragma unroll
        for (int mt = 0; mt < 8; ++mt)
#pragma unroll
            for (int j = 0; j < 2; ++j) {
                const int pp = 8 * mt + 2 * fq + j;
                float er = 0.f, ei = 0.f;
#pragma unroll
                for (int nt = 0; nt < 2; ++nt) {
                    const float2 w = *(const float2*)(W16 + ((size_t)(g * 64 + pp) * 32 + nt * 16 + fr) * 2);
                    const float xr = acc[mt][nt][2 * j], xi = acc[mt][nt][2 * j + 1];
                    er += w.x * xr - w.y * xi; ei += w.x * xi + w.y * xr;
                }
#pragma unroll
                for (int o = 1; o <= 8; o <<= 1) { er += __shfl_xor(er, o, 64); ei += __shfl_xor(ei, o, 64); }
                if (fr == 0) { const size_t sidx = (((size_t)b * 32 + g) * 32 + seg) * 128 + pp * 2; END[sidx] = er; END[sidx + 1] = ei; }
            }
    }
    __syncthreads();
}
__device__ __forceinline__ void phase_s5_carry(const Params& p) {
    const int gtid = blockIdx.x * NT + otid(), GT = gridDim.x * NT;
    const float* AB = (const float*)(p.ws + OFF_S5AB);
    const float* END = (const float*)(p.ws + OFF_S5END);
    float* CAR = (float*)(p.ws + OFF_S5CAR);
    for (int idx = gtid; idx < 4096; idx += GT) {
        const int pp = idx & 63, g = (idx >> 6) & 31, b = idx >> 11;
        const float ar = AB[4096 + g * 64 + pp], ai = AB[6144 + g * 64 + pp];
        float cr = 0.f, ci = 0.f;
        for (int seg = 0; seg < S5_NSEG; ++seg) {
            const size_t sidx = (((size_t)b * 32 + g) * 32 + seg) * 128 + pp * 2;
            CAR[sidx] = cr; CAR[sidx + 1] = ci;
            const float er = END[sidx], ei = END[sidx + 1];
            const float nr = ar * cr - ai * ci + er, ni = ar * ci + ai * cr + ei;
            cr = nr; ci = ni;
        }
    }
}

__device__ __forceinline__ void sort16_desc(float (&v)[16]) {
    constexpr int NA[60] = {0, 1, 2, 3, 4, 5, 7, 9,  0, 1, 2, 3, 6, 8, 10, 11,  0, 2, 4, 6, 7, 10, 12, 14,  0, 1, 4, 5, 6, 8, 12, 13,  1, 3, 4, 5, 8, 9, 13,  1, 2, 5, 7, 9, 11,  2, 3, 9, 11,  3, 6, 7, 10,  3, 5, 7, 9, 11,  6, 8};
    constexpr int NB[60] = {13, 12, 15, 14, 8, 6, 11, 10,  5, 7, 9, 4, 13, 14, 15, 12,  1, 3, 5, 8, 9, 11, 13, 15,  2, 3, 10, 11, 7, 9, 14, 15,  2, 12, 6, 7, 10, 11, 14,  4, 6, 8, 10, 13, 14,  4, 6, 12, 13,  5, 8, 9, 12,  4, 6, 8, 10, 12,  7, 9};
#pragma unroll
    for (int i = 0; i < 60; ++i) { const float hi = fmaxf(v[NA[i]], v[NB[i]]), lo = fminf(v[NA[i]], v[NB[i]]); v[NA[i]] = hi; v[NB[i]] = lo; }
}
__device__ __forceinline__ void merge16_desc(float (&x)[16], const float (&y)[16]) {
#pragma unroll
    for (int i = 0; i < 16; ++i) x[i] = fmaxf(x[i], y[15 - i]);
#pragma unroll
    for (int j = 8; j > 0; j >>= 1)
#pragma unroll
        for (int i = 0; i < 16; ++i) {
            const int l = i ^ j;
            if (l > i) { const float hi = fmaxf(x[i], x[l]), lo = fminf(x[i], x[l]); x[i] = hi; x[l] = lo; }
        }
}
__device__ __forceinline__ void xlane_merge16(float (&x)[16]) {
    float y[16];
#pragma unroll
    for (int i = 0; i < 16; ++i) y[i] = __shfl_xor(x[i], 16, 64);
    merge16_desc(x, y);
#pragma unroll
    for (int i = 0; i < 16; ++i) y[i] = __shfl_xor(x[i], 32, 64);
    merge16_desc(x, y);
}
__device__ __forceinline__ float pk(float v, unsigned payload, unsigned mask) { return __uint_as_float((__float_as_uint(v) & ~mask) | payload); }

__device__ __forceinline__ void phase_topk(const Params& p, unsigned char* lds) {
    const int tid = otid(), lane = tid & 63, wave = tid >> 6;
    const int c = lane & 15, q = lane >> 4;
    int* KT = (int*)lds + wave * (16 * 32);
    bf16_t* KL = (bf16_t*)(lds + 16384);
    const bf16_t* Q = (const bf16_t*)(p.ws + OFF_PROJ);
    const bf16_t* KP = (const bf16_t*)(p.ws + OFF_KEYS);
    int* EIDX = (int*)(p.ws + OFF_EIDX); float* GATE = (float*)(p.ws + OFF_GATE);
    const int h = wave;
    constexpr int CA[48] = {1, 1, 1, 1, 1, 1, 1, 1, 2, 2, 2, 2, 2, 3, 3, 3, 3, 4, 4, 4, 5, 5, 6, 6, 7, 7, 8, 9, 10, 11, 12, 13, 14, 15, -1, -1, -1, -1, -1, -1, -1, -1, -1, -1, -1, -1, -1, -1};
    constexpr int CB[48] = {0, 1, 2, 3, 4, 5, 6, 7, 0, 1, 2, 3, 4, 0, 1, 2, 3, 0, 1, 2, 0, 1, 0, 1, 0, 1, 0, 0, 0, 0, 0, 0, 0, 0, -1, -1, -1, -1, -1, -1, -1, -1, -1, -1, -1, -1, -1, -1};
    {
        const uint4* ks = (const uint4*)KP; uint4* kd = (uint4*)KL;
#pragma unroll
        for (int i = 0; i < 8; ++i) kd[tid + NT * i] = ks[tid + NT * i];
        __syncthreads();
    }
    bf16x8 cq[8];
    {
        const int tg0 = (int)blockIdx.x < NTOK / 16 ? (int)blockIdx.x : 0;
#pragma unroll
        for (int i = 0; i < 8; ++i) cq[i] = *(const bf16x8*)(Q + (size_t)(tg0 * 16 + c) * 2048 + h * 256 + i * 32 + q * 8);
    }
    for (int tg = blockIdx.x; tg < NTOK / 16; tg += gridDim.x) {
        const int tok0 = tg * 16;
        const int tgn = (tg + (int)gridDim.x < NTOK / 16) ? tg + (int)gridDim.x : tg;
        unsigned koff = 16384u; asm volatile("" : "+v"(koff));
        const LAS bf16_t* KPi = (const LAS bf16_t*)((LAS unsigned char*)lds + koff);
        float top[2][16];
#pragma unroll
        for (int half = 0; half < 2; ++half) {
            f32x4 acc[8];
#pragma unroll
            for (int m = 0; m < 8; ++m) acc[m] = (f32x4){0.f, 0.f, 0.f, 0.f};
#pragma unroll
            for (int kt = 0; kt < 4; ++kt) {
                const bf16x8 bq = cq[half * 4 + kt];
#pragma unroll
                for (int m = 0; m < 8; ++m) {
                    const bf16x8 ak = *(const LAS bf16x8*)(KPi + half * 16384 + ((m * 4 + kt) * 64 + lane) * 8);
                    acc[m] = __builtin_amdgcn_mfma_f32_16x16x32_bf16(ak, bq, acc[m], 0, 0, 0);
                }
                __builtin_amdgcn_sched_barrier(0);
            }
#pragma unroll
            for (int kt = 0; kt < 4; ++kt) cq[half * 4 + kt] = *(const bf16x8*)(Q + (size_t)(tgn * 16 + c) * 2048 + h * 256 + (half * 4 + kt) * 32 + q * 8);
            float lo16[16], hi16[16];
#pragma unroll
            for (int m = 0; m < 4; ++m)
#pragma unroll
                for (int r = 0; r < 4; ++r) {
                    lo16[m * 4 + r] = pk(acc[m][r], (unsigned)(m * 16 + 4 * q + r), 127u);
                    hi16[m * 4 + r] = pk(acc[m + 4][r], (unsigned)((m + 4) * 16 + 4 * q + r), 127u);
                }
            sort16_desc(lo16);
            sort16_desc(hi16);
            merge16_desc(lo16, hi16);
            xlane_merge16(lo16);
#pragma unroll
            for (int i = 0; i < 16; ++i) top[half][i] = lo16[i];
        }
        if (q == 0) {
#pragma unroll
            for (int i = 0; i < 16; i += 4) {
                *(int4*)(KT + c * 32 + i) = make_int4(__float_as_int(top[0][i]) & 127, __float_as_int(top[0][i + 1]) & 127, __float_as_int(top[0][i + 2]) & 127, __float_as_int(top[0][i + 3]) & 127);
                *(int4*)(KT + c * 32 + 16 + i) = make_int4(__float_as_int(top[1][i]) & 127, __float_as_int(top[1][i + 1]) & 127, __float_as_int(top[1][i + 2]) & 127, __float_as_int(top[1][i + 3]) & 127);
            }
        }
        float g0[16], g1[16], g2[16], g3[16];
#pragma unroll
        for (int b2 = 0; b2 < 16; ++b2) g0[b2] = pk(top[0][0] + top[1][b2], (unsigned)b2, 255u);
#pragma unroll
        for (int n = 0; n < 16; ++n) {
            g1[n] = (CA[n] >= 0) ? pk(top[0][CA[n] < 0 ? 0 : CA[n]] + top[1][CB[n] < 0 ? 0 : CB[n]], (unsigned)(CA[n] * 16 + CB[n]), 255u) : -INFINITY;
            g2[n] = (CA[16 + n] >= 0) ? pk(top[0][CA[16 + n] < 0 ? 0 : CA[16 + n]] + top[1][CB[16 + n] < 0 ? 0 : CB[16 + n]], (unsigned)(CA[16 + n] * 16 + CB[16 + n]), 255u) : -INFINITY;
            g3[n] = (CA[32 + n] >= 0) ? pk(top[0][CA[32 + n] < 0 ? 0 : CA[32 + n]] + top[1][CB[32 + n] < 0 ? 0 : CB[32 + n]], (unsigned)(CA[32 + n] * 16 + CB[32 + n]), 255u) : -INFINITY;
        }
        sort16_desc(g0); sort16_desc(g1); sort16_desc(g2); sort16_desc(g3);
        merge16_desc(g0, g1); merge16_desc(g2, g3); merge16_desc(g0, g2);
        float sum = 0.f, ex[16];
        const float mx = __uint_as_float(__float_as_uint(g0[0]) & ~255u);
#pragma unroll
        for (int r = 0; r < 16; ++r) { ex[r] = fexp(__uint_as_float(__float_as_uint(g0[r]) & ~255u) - mx); sum += ex[r]; }
        const float inv = 1.0f / sum;
        __syncthreads();
        int eo[4]; float go[4];
#pragma unroll
        for (int i = 0; i < 4; ++i) {
            const float xv = (q == 0) ? g0[i] : (q == 1) ? g0[4 + i] : (q == 2) ? g0[8 + i] : g0[12 + i];
            const float xe = (q == 0) ? ex[i] : (q == 1) ? ex[4 + i] : (q == 2) ? ex[8 + i] : ex[12 + i];
            const unsigned pl = __float_as_uint(xv) & 255u;
            eo[i] = KT[c * 32 + (pl >> 4)] * 128 + KT[c * 32 + 16 + (pl & 15u)];
            go[i] = xe * inv;
        }
        const size_t o = ((size_t)(tok0 + c) * 8 + h) * 16 + 4 * q;
        *(int4*)(EIDX + o) = make_int4(eo[0], eo[1], eo[2], eo[3]);
        *(float4*)(GATE + o) = make_float4(go[0], go[1], go[2], go[3]);
        __syncthreads();
    }
}

typedef float f32x2_t __attribute__((ext_vector_type(2)));
constexpr int CW_XRANK = 4096;
__device__ __forceinline__ void peer_role(const Params& p, int my_xcc, int my_rank, int& slice, int& rank) {
    const unsigned* ctl = (const unsigned*)(p.ws + OFF_CTL);
    bool even = (gridDim.x % 8u) == 0u;
#pragma unroll
    for (int x = 0; x < 8; ++x) even = even && (__hip_atomic_load(ctl + CW_XRANK + 64 * x, __ATOMIC_RELAXED, __HIP_MEMORY_SCOPE_AGENT) == gridDim.x / 8u);
    if (even) { slice = my_xcc; rank = my_rank; } else { slice = (int)(blockIdx.x & 7u); rank = (int)(blockIdx.x >> 3); }
}
#define ASM_LD16(dst, off, base) asm volatile("s_nop 4\n\tglobal_load_dwordx4 %0, %1, %2" : "+v"(dst) : "v"(off), "s"(base))
#define ASM_LD8(dst, off, base)  asm volatile("s_nop 4\n\tglobal_load_dwordx2 %0, %1, %2" : "+v"(dst) : "v"(off), "s"(base))
#define ASM_LD4(dst, off, base)  asm volatile("s_nop 4\n\tglobal_load_dword %0, %1, %2" : "+v"(dst) : "v"(off), "s"(base))
#define ASM_WAIT1(n, a)          asm volatile("s_waitcnt vmcnt(" #n ")" : "+v"(a))
#define ASM_WAIT2(n, a, b)       asm volatile("s_waitcnt vmcnt(" #n ")" : "+v"(a), "+v"(b))
#define PU_STEP(eC, hC, eN, hN, TOK)                                                                                                                    \
    {                                                                                                                                                   \
        const int tk = (TOK);                                                                                                                           \
        ASM_WAIT2(16, hC, eC);                                                                \
        {                                                                                                                                               \
            const int tn = (tk + tstep < NTOK) ? tk + tstep : tk, t2 = (tk + 2 * tstep < NTOK) ? tk + 2 * tstep : tk;                                  \
            ASM_LD4(hN, (unsigned)(tn * D + slice * 128 + 2 * lane) * 2u, H2b);                                                                         \
            ASM_LD8(eN, (unsigned)(t2 * 128 + 2 * lane) * 4u, Eb);                                                                                      \
        }                                                                                                                                               \
        f32x2_t hf2[8];                                                       \
        _Pragma("unroll") for (int i = 0; i < 8; ++i) { const unsigned hw = (unsigned)__shfl((int)hC, c8 * 8 + i, 64); hf2[i].x = bflo(hw); hf2[i].y = bfhi(hw); } \
        float d[16];                                                                                                                                    \
        _Pragma("unroll") for (int k = 0; k < 8; ++k) {                                                                                                 \
            const unsigned ea = (unsigned)__shfl((int)eC[0], ps * 8 + k, 64), eb = (unsigned)__shfl((int)eC[1], ps * 8 + k, 64);                        \
            _Pragma("unroll") for (int hf = 0; hf < 2; ++hf) {                                                                                          \
                const int it = 2 * k + hf;                                                                                                              \
                ASM_WAIT1(17, q[it]);                \
                f32x2_t uf[8];                                                                                                                          \
                _Pragma("unroll") for (int i = 0; i < 4; ++i) { uf[2 * i] = __builtin_amdgcn_cvt_pk_f32_fp8((int)q[it][i], false); uf[2 * i + 1] = __builtin_amdgcn_cvt_pk_f32_fp8((int)q[it][i], true); } \
                asm volatile("" : "+v"(uf[0]), "+v"(uf[1]), "+v"(uf[2]), "+v"(uf[3]), "+v"(uf[4]), "+v"(uf[5]), "+v"(uf[6]), "+v"(uf[7]));     \
                ASM_LD16(q[it], (hf ? eb : ea) * 128u + lo, Us);                          \
                f32x2_t s2 = {0.f, 0.f};                                                                                                                \
                _Pragma("unroll") for (int i = 0; i < 8; ++i) s2 = __builtin_elementwise_fma(uf[i], hf2[i], s2);                                        \
                d[it] = s2.x + s2.y;                                                                                                                    \
            }                                                                                                                                           \
        }                                                                                                                                               \
        float r8[8], r4[4], r2[2];                                                                                                                      \
        _Pragma("unroll") for (int i = 0; i < 8; ++i) { const float keep = b2 ? d[i + 8] : d[i], send = b2 ? d[i] : d[i + 8]; r8[i] = keep + __shfl_xor(send, 4, 64); } \
        _Pragma("unroll") for (int i = 0; i < 4; ++i) { const float keep = b1 ? r8[i + 4] : r8[i], send = b1 ? r8[i] : r8[i + 4]; r4[i] = keep + __shfl_xor(send, 2, 64); } \
        _Pragma("unroll") for (int i = 0; i < 2; ++i) { const float keep = b0 ? r4[i + 2] : r4[i], send = b0 ? r4[i] : r4[i + 2]; r2[i] = keep + __shfl_xor(send, 1, 64); } \
        if (tk < NTOK) *(unsigned*)(PD + (unsigned)(tk * 128 + ps * 16 + 2 * c8)) = pack2(r2[0], r2[1]);                                                \
    }
__device__ __forceinline__ void phase_pu(const Params& p, int slice_, int rank_) {
    const int slice = __builtin_amdgcn_readfirstlane(slice_), rank = __builtin_amdgcn_readfirstlane(rank_);
    const int tid = otid(), lane = tid & 63, wave = __builtin_amdgcn_readfirstlane(tid >> 6), c8 = lane & 7, ps = lane >> 3;
    const int nrank = (int)(gridDim.x >> 3);
    const unsigned char* H2b = p.ws + OFF_H;
    const unsigned char* Us = p.ws + OFF_UT8 + (size_t)slice * 16384 * 128;
    const unsigned char* Eb = p.ws + OFF_EIDX;
    const unsigned lo = 16u * (unsigned)c8;
    bf16_t* PD = (bf16_t*)(p.ws + OFF_PROJ) + (size_t)slice * NTOK * 128;
    const bool b0 = (lane & 1) != 0, b1 = (lane & 2) != 0, b2 = (lane & 4) != 0;
    const int tstep = nrank * NWAVE;
    int tok = rank * NWAVE + wave;
    u32x4_t q[16]; u32x2_t eA = {0u, 0u}, eB = {0u, 0u}; unsigned hA = 0u, hB = 0u;
#pragma unroll
    for (int i = 0; i < 16; ++i) q[i] = (u32x4_t){0u, 0u, 0u, 0u};
    {
        const int t0 = tok < NTOK ? tok : 0, t1 = tok + tstep < NTOK ? tok + tstep : t0;
        const u32x2_t e0 = *(const u32x2_t*)(Eb + (size_t)(unsigned)(t0 * 128 + 2 * lane) * 4);
#pragma unroll
        for (int k = 0; k < 8; ++k) {
            const unsigned ea = (unsigned)__shfl((int)e0[0], ps * 8 + k, 64), eb = (unsigned)__shfl((int)e0[1], ps * 8 + k, 64);
            if (k == 0) { ASM_LD4(hA, (unsigned)(t0 * D + slice * 128 + 2 * lane) * 2u, H2b); ASM_LD8(eA, (unsigned)(t1 * 128 + 2 * lane) * 4u, Eb); }
            ASM_LD16(q[2 * k], ea * 128u + lo, Us);
            ASM_LD16(q[2 * k + 1], eb * 128u + lo, Us);
        }
    }
    for (; tok < NTOK; tok += 2 * tstep) {
        PU_STEP(eA, hA, eB, hB, tok)
        PU_STEP(eB, hB, eA, hA, tok + tstep)
    }
    asm volatile("s_waitcnt vmcnt(0)" ::: "memory");
}
#undef PU_STEP
__device__ __forceinline__ void phase_pw(const Params& p) {
    const int gtid = blockIdx.x * NT + otid(), GT = gridDim.x * NT;
    const unsigned* PD2 = (const unsigned*)(p.ws + OFF_PROJ);
    const int2* EIDX2 = (const int2*)(p.ws + OFF_EIDX); const float2* GATE2 = (const float2*)(p.ws + OFF_GATE);
    const float* ISU = (const float*)(p.ws + OFF_ISU); const float* ISV = (const float*)(p.ws + OFF_ISV);
    float2* WG2 = (float2*)(p.ws + OFF_WG);
    for (int i2 = gtid; i2 < NTOK * 64; i2 += GT) {
        float s0 = 0.f, s1 = 0.f;
#pragma unroll
        for (int sl = 0; sl < 8; ++sl) { const unsigned v = PD2[(size_t)sl * NTOK * 64 + i2]; s0 += bflo(v); s1 += bfhi(v); }
        const int2 e = EIDX2[i2]; const float2 g = GATE2[i2];
        WG2[i2] = make_float2(g.x * geluf_(s0 * ISU[e.x]) * ISV[e.x], g.y * geluf_(s1 * ISU[e.y]) * ISV[e.y]);
    }
}
#define ASM_WAIT4(n, a, b, c, d) asm volatile("s_waitcnt vmcnt(" #n ")" : "+v"(a), "+v"(b), "+v"(c), "+v"(d))
#define PV_STEP(eC, wC, xC, mC, eN, wN, xN, mN, TOK)                                                                                                    \
    {                                                                                                                                                   \
        const int tk = (TOK);                                                                                                                           \
        ASM_WAIT4(16, eC, wC, xC, mC);                                                        \
        {                                                                                                                                               \
            const int tn = (tk + tstep < NTOK) ? tk + tstep : tk, t2 = (tk + 2 * tstep < NTOK) ? tk + 2 * tstep : tk;                                  \
            ASM_LD8(wN, (unsigned)(tn * 128 + 2 * lane) * 4u, Wb);                                                                                      \
            ASM_LD8(xN, (unsigned)(tn * D + ch) * 4u, Xb);                                                                                              \
            ASM_LD4(mN, (unsigned)(tn * D + ch) * 2u, Mb);                                                                                              \
            ASM_LD8(eN, (unsigned)(t2 * 128 + 2 * lane) * 4u, Eb);                                                                                      \
        }                                                                                                                                               \
        f32x2_t acc2[8];                                                                                                                                \
        _Pragma("unroll") for (int i = 0; i < 8; ++i) acc2[i] = (f32x2_t){0.f, 0.f};                                                                    \
        _Pragma("unroll") for (int k = 0; k < 8; ++k) {                                                                                                 \
            const unsigned ea = (unsigned)__shfl((int)eC[0], ps * 8 + k, 64), eb = (unsigned)__shfl((int)eC[1], ps * 8 + k, 64);                        \
            const float wa = __uint_as_float((unsigned)__shfl((int)wC[0], ps * 8 + k, 64)), wb = __uint_as_float((unsigned)__shfl((int)wC[1], ps * 8 + k, 64)); \
            _Pragma("unroll") for (int hf = 0; hf < 2; ++hf) {                                                                                          \
                const int it = 2 * k + hf;                                                                                                              \
                ASM_WAIT1(19, q[it]);               \
                f32x2_t vf[8];                                                                                                                          \
                _Pragma("unroll") for (int i = 0; i < 4; ++i) { vf[2 * i] = __builtin_amdgcn_cvt_pk_f32_fp8((int)q[it][i], false); vf[2 * i + 1] = __builtin_amdgcn_cvt_pk_f32_fp8((int)q[it][i], true); } \
                asm volatile("" : "+v"(vf[0]), "+v"(vf[1]), "+v"(vf[2]), "+v"(vf[3]), "+v"(vf[4]), "+v"(vf[5]), "+v"(vf[6]), "+v"(vf[7]));     \
                ASM_LD16(q[it], (hf ? eb : ea) * 128u + lo, Vs);                          \
                const float wsc = hf ? wb : wa;                                                                                                         \
                const f32x2_t ww = {wsc, wsc};                                                                                                          \
                _Pragma("unroll") for (int i = 0; i < 8; ++i) acc2[i] = __builtin_elementwise_fma(vf[i], ww, acc2[i]);                                  \
            }                                                                                                                                           \
        }                                                                                                                                               \
        float acc[16];                                                                                                                                  \
        _Pragma("unroll") for (int i = 0; i < 8; ++i) { acc[2 * i] = acc2[i].x; acc[2 * i + 1] = acc2[i].y; }                                           \
        float r8[8], r4[4], r2[2];                                                                                                                      \
        _Pragma("unroll") for (int i = 0; i < 8; ++i) { const float keep = b5 ? acc[i + 8] : acc[i], send = b5 ? acc[i] : acc[i + 8]; r8[i] = keep + __shfl_xor(send, 32, 64); } \
        _Pragma("unroll") for (int i = 0; i < 4; ++i) { const float keep = b4 ? r8[i + 4] : r8[i], send = b4 ? r8[i] : r8[i + 4]; r4[i] = keep + __shfl_xor(send, 16, 64); } \
        _Pragma("unroll") for (int i = 0; i < 2; ++i) { const float keep = b3 ? r4[i + 2] : r4[i], send = b3 ? r4[i] : r4[i + 2]; r2[i] = keep + __shfl_xor(send, 8, 64); } \
        const bool hbt = (tk >> 14) != 0;                                                                                                               \
        const float2 gv = hbt ? gv1 : gv0, g1 = hbt ? g11 : g10;                                                                                        \
        if (tk < NTOK) *(float2*)(out + (unsigned)(tk * D + ch)) = make_float2(__uint_as_float(xC[0]) + g1.x * bflo(mC) + gv.x * r2[0], __uint_as_float(xC[1]) + g1.y * bfhi(mC) + gv.y * r2[1]); \
    }
__device__ __forceinline__ void phase_pv(const Params& p, int slice_, int rank_) {
    const int slice = __builtin_amdgcn_readfirstlane(slice_), rank = __builtin_amdgcn_readfirstlane(rank_);
    const int tid = otid(), lane = tid & 63, wave = __builtin_amdgcn_readfirstlane(tid >> 6), c8 = lane & 7, ps = lane >> 3;
    const int nrank = (int)(gridDim.x >> 3);
    const unsigned char* Vs = p.ws + OFF_VT8 + (size_t)slice * 16384 * 128;
    const unsigned char* Eb = p.ws + OFF_EIDX; const unsigned char* Wb = p.ws + OFF_WG;
    const unsigned char* Xb = (const unsigned char*)p.in[0]; const unsigned char* Mb = p.ws + OFF_MIX;
    const unsigned lo = 16u * (unsigned)c8;
    const float* mod = (const float*)(p.ws + OFF_MOD);
    float* out = p.out;
    const bool b3 = (lane & 8) != 0, b4 = (lane & 16) != 0, b5 = (lane & 32) != 0;
    const int tstep = nrank * NWAVE;
    const int ch = slice * 128 + c8 * 16 + 2 * ps;
    const float2 gv0 = *(const float2*)(mod + 5120 + ch), gv1 = *(const float2*)(mod + 6144 + 5120 + ch);
    const float2 g10 = *(const float2*)(mod + 2048 + ch), g11 = *(const float2*)(mod + 6144 + 2048 + ch);
    int tok = rank * NWAVE + wave;
    u32x4_t q[16];
    u32x2_t eA = {0u, 0u}, eB = {0u, 0u}, wA = {0u, 0u}, wB = {0u, 0u}, xA = {0u, 0u}, xB = {0u, 0u}; unsigned mA = 0u, mB = 0u;
#pragma unroll
    for (int i = 0; i < 16; ++i) q[i] = (u32x4_t){0u, 0u, 0u, 0u};
    {
        const int t0 = tok < NTOK ? tok : 0, t1 = tok + tstep < NTOK ? tok + tstep : t0;
        const u32x2_t e0 = *(const u32x2_t*)(Eb + (size_t)(unsigned)(t0 * 128 + 2 * lane) * 4);
#pragma unroll
        for (int k = 0; k < 8; ++k) {
            const unsigned ea = (unsigned)__shfl((int)e0[0], ps * 8 + k, 64), eb = (unsigned)__shfl((int)e0[1], ps * 8 + k, 64);
            if (k == 0) {
                ASM_LD8(wA, (unsigned)(t0 * 128 + 2 * lane) * 4u, Wb); ASM_LD8(xA, (unsigned)(t0 * D + ch) * 4u, Xb);
                ASM_LD4(mA, (unsigned)(t0 * D + ch) * 2u, Mb); ASM_LD8(eA, (unsigned)(t1 * 128 + 2 * lane) * 4u, Eb);
            }
            ASM_LD16(q[2 * k], ea * 128u + lo, Vs);
            ASM_LD16(q[2 * k + 1], eb * 128u + lo, Vs);
        }
    }
    for (; tok < NTOK; tok += 2 * tstep) {
        PV_STEP(eA, wA, xA, mA, eB, wB, xB, mB, tok)
        PV_STEP(eB, wB, xB, mB, eA, wA, xA, mA, tok + tstep)
    }
    asm volatile("s_waitcnt vmcnt(0)" ::: "memory");
}
#undef PV_STEP
__device__ __forceinline__ void phase_pn(const Params& p) {
    const int tid = otid(), lane = tid & 63, wave = tid >> 6;
    const int gw = blockIdx.x * NWAVE + wave, GW = gridDim.x * NWAVE;
    const float* fnw = p.in[25];
    float4 fw[4];
#pragma unroll
    for (int j = 0; j < 4; ++j) fw[j] = ((const float4*)fnw)[j * 64 + lane];
    for (int row = gw; row < NTOK; row += GW) {
        float4* xr = (float4*)(p.out + (size_t)row * D);
        float4 v[4]; float ss = 0.f;
#pragma unroll
        for (int j = 0; j < 4; ++j) { v[j] = xr[j * 64 + lane]; ss += v[j].x * v[j].x + v[j].y * v[j].y + v[j].z * v[j].z + v[j].w * v[j].w; }
        ss = wave_sum(ss);
        const float rstd = rsqrtf(ss * (1.0f / D) + EPS);
#pragma unroll
        for (int j = 0; j < 4; ++j) xr[j * 64 + lane] = make_float4(v[j].x * rstd * fw[j].x, v[j].y * rstd * fw[j].y, v[j].z * rstd * fw[j].z, v[j].w * rstd * fw[j].w);
    }
}

#define XB_TMO      128
#define XB_XCNT(j)  (256  + 64 * (j))
#define XB_XSUB(j)  (1280 + 64 * (j))
#define XB_XGEN(j)  (2304 + 64 * (j))
#define XB_TOP      3328
#define XB_TOPGEN   3392
#define XCD_BAR_WORDS 3456
#define XB_SPIN_CAP (1u << 18)

__device__ __forceinline__ unsigned xb_ld(unsigned* p)              { return __hip_atomic_load(p, __ATOMIC_RELAXED, __HIP_MEMORY_SCOPE_AGENT); }
__device__ __forceinline__ unsigned xb_add(unsigned* p, unsigned v) { return __hip_atomic_fetch_add(p, v, __ATOMIC_RELAXED, __HIP_MEMORY_SCOPE_AGENT); }
__device__ __forceinline__ unsigned xb_xcc_id() { return (unsigned)__builtin_amdgcn_s_getreg((3 << 11) | 20) & 0xFu; }
#define XB_SPIN(cond, bar) do { unsigned _sp = 0; while (cond) { __builtin_amdgcn_s_sleep(1); \
    if ((++_sp & 255u) == 0u) { if (xb_ld(&(bar)[XB_TMO])) break; if (_sp > XB_SPIN_CAP) { atomicAdd(&(bar)[XB_TMO], 1u); break; } } } } while (0)

struct XcdBarrier {
    unsigned* bar; unsigned x;
    volatile LAS unsigned* st;
};

__device__ __forceinline__ XcdBarrier xcd_barrier_post(unsigned* bar, volatile LAS unsigned* st) {
    XcdBarrier b; b.bar = bar; b.x = xb_xcc_id(); b.st = st;
    if (threadIdx.x == 0) (void)xb_add(&bar[XB_XCNT(b.x)], 1u);
    return b;
}
__device__ __forceinline__ void xcd_barrier_complete(unsigned* bar, unsigned x, unsigned& nloc, unsigned& nx) {
    const unsigned G = gridDim.x * gridDim.y * gridDim.z;
    unsigned sum, cnt, mine, sp = 0u;
    for (;;) {
        sum = 0u; cnt = 0u; mine = 0u;
#pragma unroll
        for (unsigned j = 0; j < 16; ++j) { const unsigned c = xb_ld(&bar[XB_XCNT(j)]); sum += c; cnt += (c > 0u) ? 1u : 0u; mine = (j == x) ? c : mine; }
        if (sum == G) break;
        __builtin_amdgcn_s_sleep(1);
        if ((++sp & 255u) == 0u) { if (xb_ld(&bar[XB_TMO])) break; if (sp > XB_SPIN_CAP) { atomicAdd(&bar[XB_TMO], 1u); break; } }
    }
    nloc = mine > 0u ? mine : 1u; nx = cnt > 0u ? cnt : 1u;
}

__device__ __forceinline__ void xcd_barrier(const XcdBarrier& b) {
    asm volatile("s_waitcnt vmcnt(0)" ::: "memory");
    __syncthreads();
    if (threadIdx.x == 0) {
        unsigned* bar = b.bar;
        __builtin_amdgcn_s_waitcnt(0);
        unsigned nloc = b.st[0], nx = b.st[1];
        if (nloc == 0u) { xcd_barrier_complete(bar, b.x, nloc, nx); b.st[0] = nloc; b.st[1] = nx; }
        const unsigned old = xb_add(&bar[XB_XSUB(b.x)], 1u);
        const unsigned gen = old / nloc;
        if (old + 1u == (gen + 1u) * nloc) {
            __builtin_amdgcn_fence(__ATOMIC_RELEASE, "agent");
            asm volatile("s_waitcnt vmcnt(0)" ::: "memory");
            const unsigned og = xb_add(&bar[XB_TOP], 1u);
            const unsigned tg = og / nx;
            if (og + 1u == (tg + 1u) * nx) xb_add(&bar[XB_TOPGEN], 1u);
            else XB_SPIN(xb_ld(&bar[XB_TOPGEN]) == tg, bar);
            __builtin_amdgcn_fence(__ATOMIC_ACQUIRE, "agent");
            xb_add(&bar[XB_XGEN(b.x)], 1u);
            asm volatile("s_waitcnt vmcnt(0)" ::: "memory");
        } else {
            XB_SPIN(xb_ld(&bar[XB_XGEN(b.x)]) == gen, bar);
            __builtin_amdgcn_fence(__ATOMIC_ACQUIRE, "agent");
            asm volatile("s_waitcnt vmcnt(0)" ::: "memory");
        }
    }
    __syncthreads();
}

constexpr int N_PHASES = 15;
template <int PH>
__device__ __forceinline__ void run_phase(const Params& p, unsigned char* lds, int xcc, int xrank) {
    unsigned char* ws = p.ws;
    if (PH == 0) phase_prep(p, lds);
    if (PH == 1) phase_norm<false>(p, p.in[0], nullptr, p.in[4], 0, 1024, (bf16_t*)(ws + OFF_H));
    if (PH == 2) gemm_run(lds, (const bf16_t*)(ws + OFF_H), (const bf16_t*)(ws + OFF_WIN), NTOK, INW, D, pg8::EpiBf16<0>{(bf16_t*)(ws + OFF_PROJ), INW, nullptr, 0, 0});
    if (PH == 3) { phase_hg1(p, lds); phase_s5_end(p, lds); }
    if (PH == 4) { phase_hg2(p); phase_s5_carry(p); }
    if (PH == 5) { phase_hg3(p, lds); phase_s5_scan<true>(p, lds); }
    if (PH == 6) gemm_run(lds, (const bf16_t*)(ws + OFF_YG), (const bf16_t*)(ws + OFF_WGLU), NTOK, 512, 512, EpiGlu{(const bf16_t*)(ws + OFF_YG), p.in[19], (bf16_t*)(ws + OFF_OCAT)});
    if (PH == 7) gemm_run(lds, (const bf16_t*)(ws + OFF_OCAT), (const bf16_t*)(ws + OFF_WOUT), NTOK, D, D, pg8::EpiBf16<0>{(bf16_t*)(ws + OFF_MIX), D, nullptr, 0, 0});
    if (PH == 8) phase_norm<true>(p, p.in[0], (const bf16_t*)(ws + OFF_MIX), p.in[5], 3072, 4096, (bf16_t*)(ws + OFF_H));
    if (PH == 9) gemm_run(lds, (const bf16_t*)(ws + OFF_H), (const bf16_t*)(ws + OFF_WQ), NTOK, 2048, D, pg8::EpiBf16<0>{(bf16_t*)(ws + OFF_PROJ), 2048, nullptr, 0, 0});
    if (PH == 10) phase_topk(p, lds);
    if (PH == 11) { int sl, rk; peer_role(p, xcc, xrank, sl, rk); phase_pu(p, sl, rk); }
    if (PH == 12) phase_pw(p);
    if (PH == 13) { int sl, rk; peer_role(p, xcc, xrank, sl, rk); phase_pv(p, sl, rk); }
    if (PH == 14) phase_pn(p);
}

template <int PH>
__global__ void __launch_bounds__(NT, 2) k_phase(Params p) {
    __shared__ __attribute__((aligned(16))) unsigned char lds[LDS_BYTES];
    run_phase<PH>(p, lds, 99, 0);
}

#if ONE_LAUNCH
#ifndef REP_MASK
#define REP_MASK 0
#endif
template <int PH>
__device__ __forceinline__ void run_rep(const Params& p, unsigned char* lds, cg::grid_group& grid, const XcdBarrier& bar, int xcc, int xrank) {
    run_phase<PH>(p, lds, xcc, xrank);
    if (PH == 0) grid.sync();
    else if (PH != N_PHASES - 1) xcd_barrier(bar);
    if ((REP_MASK >> PH) & 1) { run_phase<PH>(p, lds, xcc, xrank); xcd_barrier(bar); }
}
__global__ void __launch_bounds__(NT, 2) k_mega(Params p) {
    __shared__ __attribute__((aligned(16))) unsigned char lds[LDS_BYTES];
    cg::grid_group grid = cg::this_grid();
    volatile LAS unsigned* st = (volatile LAS unsigned*)(LAS unsigned char*)(lds + LDS_PHASE_BYTES);
    if (threadIdx.x < 4) st[threadIdx.x] = 0u;
    __syncthreads();
    const XcdBarrier bar = xcd_barrier_post((unsigned*)(p.ws + OFF_CTL), st);
    const int xcc = __builtin_amdgcn_readfirstlane((int)bar.x);
    if (threadIdx.x == 0) st[2] = (xcc < 8) ? xb_add((unsigned*)(p.ws + OFF_CTL) + CW_XRANK + 64 * xcc, 1u) : 0xffffu;
    __syncthreads();
    const int xrank = __builtin_amdgcn_readfirstlane((int)st[2]);
    run_rep<0>(p, lds, grid, bar, xcc, xrank); run_rep<1>(p, lds, grid, bar, xcc, xrank); run_rep<2>(p, lds, grid, bar, xcc, xrank); run_rep<3>(p, lds, grid, bar, xcc, xrank);
    run_rep<4>(p, lds, grid, bar, xcc, xrank); run_rep<5>(p, lds, grid, bar, xcc, xrank); run_rep<6>(p, lds, grid, bar, xcc, xrank); run_rep<7>(p, lds, grid, bar, xcc, xrank);
    run_rep<8>(p, lds, grid, bar, xcc, xrank); run_rep<9>(p, lds, grid, bar, xcc, xrank); run_rep<10>(p, lds, grid, bar, xcc, xrank); run_rep<11>(p, lds, grid, bar, xcc, xrank);
    run_rep<12>(p, lds, grid, bar, xcc, xrank); run_rep<13>(p, lds, grid, bar, xcc, xrank); run_rep<14>(p, lds, grid, bar, xcc, xrank);
}
#endif

template <int PH>
static void launch_phase(const Params& p, int grid, hipStream_t stream) {
    hipLaunchKernelGGL(k_phase<PH>, dim3(grid), dim3(NT), 0, stream, p);
}

extern "C" void kernel_launch(void* const* d_in, const int* in_sizes, int n_in, void* d_out, int out_size, void* d_ws, size_t ws_size, hipStream_t stream) {
    if (n_in != 26 || ws_size < WS_END) { fprintf(stderr, "kernel_launch: unexpected inputs (n_in %d, ws %zu)\n", n_in, ws_size); return; }
    Params p{};
    for (int i = 0; i < 26; ++i) p.in[i] = (const float*)d_in[i];
    p.out = (float*)d_out; p.ws = (unsigned char*)d_ws;
#if ONE_LAUNCH
    static int grid = 0;
    if (!grid) {
        int dev = 0, cus = 0, per_cu = 0;
        hipGetDevice(&dev);
        hipDeviceGetAttribute(&cus, hipDeviceAttributeMultiprocessorCount, dev);
        hipOccupancyMaxActiveBlocksPerMultiprocessor(&per_cu, k_mega, NT, 0);
        grid = (per_cu >= 1 ? cus : 0) & ~7;
        if (grid <= 0) { fprintf(stderr, "kernel_launch: no resident grid (cus %d, blocks per CU %d)\n", cus, per_cu); grid = -1; }
    }
    if (grid < 0) return;
    (void)hipMemsetAsync((unsigned char*)d_ws + OFF_CTL, 0, 32768, stream);
    void* args[] = {&p};
    hipError_t e = hipLaunchCooperativeKernel((void*)k_mega, dim3(grid), dim3(NT), args, 0, stream);
    if (e != hipSuccess) fprintf(stderr, "cooperative launch failed: %s (grid %d)\n", hipGetErrorString(e), grid);
#else
    const int grid = 256;
    launch_phase<0>(p, grid, stream); launch_phase<1>(p, grid, stream); launch_phase<2>(p, grid, stream);
    launch_phase<3>(p, grid, stream); launch_phase<4>(p, grid, stream); launch_phase<5>(p, grid, stream);
    launch_phase<6>(p, grid, stream); launch_phase<7>(p, grid, stream); launch_phase<8>(p, grid, stream);
    launch_phase<9>(p, grid, stream); launch_phase<10>(p, grid, stream); launch_phase<11>(p, grid, stream);
    launch_phase<12>(p, grid, stream); launch_phase<13>(p, grid, stream); launch_phase<14>(p, grid, stream);
#endif
}
```
